# Optimizing an MI355X kernel written in HIP

```python
import math, functools
import jax
import jax.numpy as jnp
from jax import lax
import numpy as np

D_MODEL = 1024
BATCH = 1
SEQ = 16384
DEPTH = 1
DEC_BATCH = 32
DEC_SEQ = 8
PAST_LEN = 16384
PAGE_SIZE = 128

HD_A = 64
H_A = (D_MODEL // 2) // HD_A
D_A = H_A * HD_A
DK_M = 128
DV_M = 128
H_M = (D_MODEL // 2) // DV_M
D_M = H_M * DV_M
D_MIX = D_A + D_M
DILATED_PATTERNS = ((128, 1), (512, 4), (2048, 16))
W_MAX = max(w for w, _ in DILATED_PATTERNS)
N_BUCKETS = 32
BUCKET_MAX_DIST = W_MAX
MLSTM_CHUNK = 128
D_FF = 2816
CONV_W = 3
RMS_EPS = 1e-6
IN_SIZES = (D_A, D_A, D_A, H_M * DK_M, H_M * DK_M, H_M * DV_M, D_M, H_M, H_M)
N_IN = sum(IN_SIZES)

kernel_name = 'hymba_dilated_mlstm_convffn_step'


def rmsnorm(x, g):
    xf = x.astype(jnp.float32)
    y = xf * lax.rsqrt(jnp.mean(xf * xf, axis=-1, keepdims=True) + RMS_EPS)
    return (y * g.astype(jnp.float32)).astype(x.dtype)


def t5_bucket(dist):
    max_exact = N_BUCKETS // 2
    d = jnp.maximum(dist, max_exact).astype(jnp.float32)
    large = max_exact + (jnp.log(d / max_exact) / math.log(BUCKET_MAX_DIST / max_exact)
                         * (N_BUCKETS - max_exact)).astype(jnp.int32)
    large = jnp.minimum(large, N_BUCKETS - 1)
    return jnp.where(dist < max_exact, dist, large)


def pattern_bias(rel_bias, win, dil):
    j = jnp.arange(win // dil + 1)
    return rel_bias[t5_bucket(j * dil)].T.astype(jnp.float32)


def dilated_band_attention(q, k, v, bias_hj, win, dil):
    B, S, H, E = q.shape
    span = win // dil
    blk = span
    L = S // dil
    nb = -(-L // blk)
    Lp = nb * blk

    def to_blocks(t):
        t = t.reshape(B, L, dil, H, E).transpose(0, 2, 1, 3, 4)
        t = jnp.pad(t, ((0, 0), (0, 0), (0, Lp - L), (0, 0), (0, 0)))
        return t.reshape(B, dil, nb, blk, H, E)

    def with_prev(t):
        prev = jnp.pad(t[:, :, :-1], ((0, 0), (0, 0), (1, 0), (0, 0), (0, 0), (0, 0)))
        return jnp.concatenate([prev, t], axis=3)

    qb = to_blocks(q)
    kk = with_prev(to_blocks(k))
    vv = with_prev(to_blocks(v))
    qi = jnp.arange(blk)[:, None]
    ki = jnp.arange(2 * blk)[None, :]
    steps = blk + qi - ki
    valid = (((steps >= 0) & (steps <= span))[None]
             & ((jnp.arange(nb) > 0)[:, None, None] | (ki >= blk)[None]))
    bias = bias_hj[:, jnp.clip(steps, 0, span)]
    s = jnp.einsum('brnqhe,brnkhe->brnhqk', qb, kk, preferred_element_type=jnp.float32) * (E ** -0.5)
    s = jnp.where(valid[None, None, :, None], s + bias[None, None, None], -jnp.inf)
    lse = jax.nn.logsumexp(s, axis=-1)
    p = jnp.exp(s - lse[..., None]).astype(vv.dtype)
    o = jnp.einsum('brnhqk,brnkhe->brnqhe', p, vv)
    o = o.reshape(B, dil, Lp, H, E)[:, :, :L].transpose(0, 2, 1, 3, 4).reshape(B, S, H, E)
    lse = lse.transpose(0, 1, 2, 4, 3).reshape(B, dil, Lp, H)[:, :, :L].transpose(0, 2, 1, 3).reshape(B, S, H)
    return o, lse


def dilated_gather_attention(q, k_all, v_all, bias_hj, win, dil):
    B, T, H, E = q.shape
    wb = k_all.shape[1] - T
    nk = win // dil + 1
    idx = wb + jnp.arange(T)[:, None] - jnp.arange(nk)[None, :] * dil
    valid = idx >= 0
    safe = jnp.maximum(idx, 0)
    kg = jnp.take(k_all, safe, axis=1)
    vg = jnp.take(v_all, safe, axis=1)
    s = jnp.einsum('bthe,btjhe->bhtj', q, kg, preferred_element_type=jnp.float32) * (E ** -0.5)
    s = jnp.where(valid[None, None], s + bias_hj[None, :, None, :], -jnp.inf)
    lse = jax.nn.logsumexp(s, axis=-1)
    p = jnp.exp(s - lse[..., None]).astype(vg.dtype)
    o = jnp.einsum('bhtj,btjhe->bthe', p, vg)
    return o, lse.transpose(0, 2, 1)


def combine_dilations(outs, lses):
    w = jax.nn.softmax(jnp.stack(lses), axis=0)
    return jnp.einsum('gbth,gbthe->bthe', w, jnp.stack(outs).astype(jnp.float32))


def attn_prompt(q, k, v, rel_bias):
    outs, lses = [], []
    for win, dil in DILATED_PATTERNS:
        o, l = dilated_band_attention(q, k, v, pattern_bias(rel_bias, win, dil), win, dil)
        outs.append(o)
        lses.append(l)
    wb = min(W_MAX, q.shape[1])
    return combine_dilations(outs, lses), k[:, -wb:], v[:, -wb:]


def attn_sample(q, k, v, rel_bias, cache_k, cache_v):
    wb = cache_k.shape[1]
    k_all = jnp.concatenate([cache_k.astype(k.dtype), k], axis=1)
    v_all = jnp.concatenate([cache_v.astype(v.dtype), v], axis=1)
    outs, lses = [], []
    for win, dil in DILATED_PATTERNS:
        o, l = dilated_gather_attention(q, k_all, v_all, pattern_bias(rel_bias, win, dil), win, dil)
        outs.append(o)
        lses.append(l)
    return combine_dilations(outs, lses), k_all[:, -wb:], v_all[:, -wb:]


def mlstm_chunkwise(q, k, v, ig, lf, C0, n0, m0):
    B, S, H, DK = q.shape
    DV = v.shape[-1]
    c = math.gcd(S, MLSTM_CHUNK)
    nc = S // c

    def chunks(t):
        return jnp.moveaxis(t.reshape((B, nc, c) + t.shape[2:]), 1, 0)

    causal = jnp.tril(jnp.ones((c, c), dtype=bool))

    def step(carry, inp):
        C, n, m = carry
        qc, kc, vc, ic, fc = inp
        b = jnp.cumsum(fc, axis=1).transpose(0, 2, 1)
        it = ic.transpose(0, 2, 1)
        D = jnp.where(causal, b[..., :, None] - b[..., None, :] + it[..., None, :], -jnp.inf)
        inter = b + m[..., None]
        mt = jnp.maximum(inter, jnp.max(D, axis=-1))
        Sm = jnp.einsum('bthk,bshk->bhts', qc, kc) * jnp.exp(D - mt[..., None])
        iw = jnp.exp(inter - mt)
        num = jnp.einsum('bhts,bshv->bhtv', Sm, vc) + iw[..., None] * jnp.einsum('bthk,bhkv->bhtv', qc, C)
        den = jnp.sum(Sm, axis=-1) + iw * jnp.einsum('bthk,bhk->bht', qc, n)
        h = num / jnp.maximum(jnp.abs(den), jnp.exp(-mt))[..., None]
        bL = b[..., -1]
        g = bL[..., None] - b + it
        m_new = jnp.maximum(bL + m, jnp.max(g, axis=-1))
        ws = jnp.exp(g - m_new[..., None])
        wc = jnp.exp(bL + m - m_new)
        C_new = wc[..., None, None] * C + jnp.einsum('bhs,bshk,bshv->bhkv', ws, kc, vc)
        n_new = wc[..., None] * n + jnp.einsum('bhs,bshk->bhk', ws, kc)
        return (C_new, n_new, m_new), h.transpose(0, 2, 1, 3)

    (C, n, m), h = lax.scan(step, (C0, n0, m0), (chunks(q), chunks(k), chunks(v), chunks(ig), chunks(lf)))
    h = jnp.moveaxis(h, 0, 1).reshape(B, S, H, DV)
    return h, C, n, m


def causal_dwconv(u, prev, w, b):
    T = u.shape[1]
    full = jnp.concatenate([prev.astype(u.dtype), u], axis=1)
    y = b + full[:, 0:T] * w[0]
    for tap in range(1, CONV_W):
        y = y + full[:, tap:tap + T] * w[tap]
    return y, full[:, T:]


def trunk_layer(x, attn_fn, C0, n0, m0, conv_prev, rel_bias, g_mix_pre, w_in, b_igate, b_fgate,
                g_mlstm_out, w_out, g_mix_post, g_ffn_pre, w_up, conv_w, conv_b, w_down, g_ffn_post):
    B, T, _ = x.shape
    f32 = jnp.float32
    z = rmsnorm(x, g_mix_pre) @ w_in
    qa, ka, va, qm, km, vm, om, zi, zf = jnp.split(z, np.cumsum(IN_SIZES)[:-1].tolist(), axis=-1)

    def heads(t, h):
        return t.reshape(B, T, h, -1)

    att, k_state, v_state = attn_fn(heads(qa, H_A), heads(ka, H_A), heads(va, H_A), rel_bias)

    ig = zi.astype(f32) + b_igate.astype(f32)
    lf = jax.nn.log_sigmoid(zf.astype(f32) + b_fgate.astype(f32))
    hm, C, n, m = mlstm_chunkwise(heads(qm, H_M).astype(f32), heads(km, H_M).astype(f32) * (DK_M ** -0.5),
                                  heads(vm, H_M).astype(f32), ig, lf,
                                  C0.astype(f32), n0.astype(f32), m0.astype(f32))
    hm = hm * lax.rsqrt(jnp.mean(hm * hm, axis=-1, keepdims=True) + RMS_EPS) * g_mlstm_out.astype(f32).reshape(H_M, DV_M)
    hm = jax.nn.sigmoid(om.astype(f32)) * hm.reshape(B, T, D_M)

    mixed = jnp.concatenate([att.reshape(B, T, D_A).astype(x.dtype), hm.astype(x.dtype)], axis=-1) @ w_out
    x = x + rmsnorm(mixed, g_mix_post)

    u = rmsnorm(x, g_ffn_pre) @ w_up
    uc, conv_state = causal_dwconv(u, conv_prev, conv_w, conv_b)
    gate, val = jnp.split(uc, 2, axis=-1)
    y = (jax.nn.gelu(gate, approximate=True) * val) @ w_down
    x = x + rmsnorm(y, g_ffn_post)
    return x, k_state, v_state, C, n, m, conv_state


def setup_inputs(seed: int = 0) -> dict:
    key = jax.random.key(seed)
    ks = jax.random.split(key, 24)
    f32 = jnp.float32
    wb = min(W_MAX, PAST_LEN)
    nrm = lambda i, shape: jax.random.normal(ks[i], shape, dtype=f32)
    return {
        'x_prompt': nrm(0, (BATCH, SEQ, D_MODEL)),
        'x_sample': nrm(1, (DEC_BATCH, DEC_SEQ, D_MODEL)),
        'cache_attn_k': nrm(2, (DEPTH, DEC_BATCH, wb, H_A, HD_A)),
        'cache_attn_v': nrm(3, (DEPTH, DEC_BATCH, wb, H_A, HD_A)),
        'state_mlstm_C': 0.1 * nrm(4, (DEPTH, DEC_BATCH, H_M, DK_M, DV_M)),
        'state_mlstm_n': 0.1 * nrm(5, (DEPTH, DEC_BATCH, H_M, DK_M)),
        'state_mlstm_m': nrm(6, (DEPTH, DEC_BATCH, H_M)),
        'state_ffn_conv': nrm(7, (DEPTH, DEC_BATCH, CONV_W - 1, 2 * D_FF)),
        'rel_bias': 0.5 * nrm(8, (N_BUCKETS, H_A)),
        'g_mix_pre': 1.0 + 0.05 * nrm(9, (DEPTH, D_MODEL)),
        'w_in': nrm(10, (DEPTH, D_MODEL, N_IN)) * (D_MODEL ** -0.5),
        'b_igate': 0.1 * nrm(11, (DEPTH, H_M)),
        'b_fgate': jnp.linspace(3.0, 6.0, H_M, dtype=f32)[None] + 0.1 * nrm(12, (DEPTH, H_M)),
        'g_mlstm_out': 1.0 + 0.05 * nrm(13, (DEPTH, D_M)),
        'w_out': nrm(14, (DEPTH, D_MIX, D_MODEL)) * (D_MIX ** -0.5),
        'g_mix_post': 1.0 + 0.05 * nrm(15, (DEPTH, D_MODEL)),
        'g_ffn_pre': 1.0 + 0.05 * nrm(16, (DEPTH, D_MODEL)),
        'w_up': nrm(17, (DEPTH, D_MODEL, 2 * D_FF)) * (D_MODEL ** -0.5),
        'conv_w': nrm(18, (DEPTH, CONV_W, 2 * D_FF)) * (CONV_W ** -0.5),
        'conv_b': 0.01 * nrm(19, (DEPTH, 2 * D_FF)),
        'w_down': nrm(20, (DEPTH, D_FF, D_MODEL)) * (D_FF ** -0.5),
        'g_ffn_post': 1.0 + 0.05 * nrm(21, (DEPTH, D_MODEL)),
    }


def reference(x_prompt, x_sample, cache_attn_k, cache_attn_v, state_mlstm_C, state_mlstm_n, state_mlstm_m,
              state_ffn_conv, rel_bias, g_mix_pre, w_in, b_igate, b_fgate, g_mlstm_out, w_out, g_mix_post,
              g_ffn_pre, w_up, conv_w, conv_b, w_down, g_ffn_post):
    f32 = jnp.float32
    yp = x_prompt
    ys = x_sample
    new_p = [[] for _ in range(6)]
    new_s = [[] for _ in range(6)]
    for l in range(DEPTH):
        w_l = (g_mix_pre[l], w_in[l], b_igate[l], b_fgate[l], g_mlstm_out[l], w_out[l], g_mix_post[l],
               g_ffn_pre[l], w_up[l], conv_w[l], conv_b[l], w_down[l], g_ffn_post[l])
        zC = jnp.zeros((BATCH, H_M, DK_M, DV_M), f32)
        zn = jnp.zeros((BATCH, H_M, DK_M), f32)
        zm = jnp.zeros((BATCH, H_M), f32)
        zconv = jnp.zeros((BATCH, CONV_W - 1, 2 * D_FF), x_prompt.dtype)
        yp, *sp = trunk_layer(yp, attn_prompt, zC, zn, zm, zconv, rel_bias, *w_l)
        sample_attn = functools.partial(attn_sample, cache_k=cache_attn_k[l], cache_v=cache_attn_v[l])
        ys, *ss = trunk_layer(ys, sample_attn, state_mlstm_C[l], state_mlstm_n[l], state_mlstm_m[l],
                              state_ffn_conv[l], rel_bias, *w_l)
        for i in range(6):
            new_p[i].append(sp[i])
            new_s[i].append(ss[i])
    k_win_prompt = jnp.stack(new_p[0])
    v_win_prompt = jnp.stack(new_p[1])
    mlstm_C_prompt = jnp.stack(new_p[2])
    mlstm_n_prompt = jnp.stack(new_p[3])
    mlstm_m_prompt = jnp.stack(new_p[4])
    conv_prompt = jnp.stack(new_p[5])
    k_win_sample = jnp.stack(new_s[0])
    v_win_sample = jnp.stack(new_s[1])
    mlstm_C_sample = jnp.stack(new_s[2])
    mlstm_n_sample = jnp.stack(new_s[3])
    mlstm_m_sample = jnp.stack(new_s[4])
    conv_sample = jnp.stack(new_s[5])
    return (yp, ys, k_win_prompt, v_win_prompt, mlstm_C_prompt, mlstm_n_prompt, mlstm_m_prompt, conv_prompt,
            k_win_sample, v_win_sample, mlstm_C_sample, mlstm_n_sample, mlstm_m_sample, conv_sample)
```

```cpp
#include <hip/hip_runtime.h>
#include <cstdio>
#include <cstdint>
namespace pg8 {
#define PG8_LAS __attribute__((address_space(3)))
typedef unsigned short bf16_t;
typedef short bf16x8 __attribute__((ext_vector_type(8)));
typedef float f32x4 __attribute__((ext_vector_type(4)));
typedef unsigned u32x4 __attribute__((ext_vector_type(4)));
constexpr int BM = 256, BK = 64, HALF = 128, HTB = HALF * BK * 2  , STAGE_BYTES = 8 * HTB, NXCD = 8, WGM = 8;

__host__ __device__ __forceinline__ int lds_byte(int r, int c) { const int st = (r >> 4) * 2 + (c >> 5), rr = r & 15, cc = c & 31, ob = rr * 64 + cc * 2; return st * 1024 + (ob ^ (((ob >> 9) & 1) << 5)); }
__host__ __device__ __forceinline__ void stage_rc(int b, int& R, int& C) { const int st = b / 1024, sb = b % 1024, swz = sb ^ (((sb >> 9) & 1) << 5); R = (st >> 1) * 16 + swz / 64; C = (st & 1) * 32 + (swz % 64) / 2; }
__host__ __device__ __forceinline__ int perm32(int rho) { const int n = rho >> 4, i = rho & 15; return 8 * (i >> 2) + 4 * n + (i & 3); }

struct Unit { int pm, pn; };
struct Gemm { const bf16_t* A; const bf16_t* Bt; int M, N, K; };

struct StaticOrder {
    int nM, nN, nwg, G, c;
    __host__ __device__ void init(int M, int N, int G_, int c_) { nM = M / BM; nN = N / BM; nwg = nM * nN; G = G_; c = c_; }
    __host__ __device__ bool next(int i, Unit& u) const {
        const long L = (long)i * G + c; if (L >= nwg) return false;
        int wgid = (int)L; { const int q = nwg / NXCD, r = nwg % NXCD, xcd = wgid % NXCD, off = wgid / NXCD; wgid = (xcd < r ? xcd * (q + 1) : r * (q + 1) + (xcd - r) * q) + off; }
        const int nig = WGM * nN, gid = wgid / nig, fm = gid * WGM, gsz = (nM - fm) < WGM ? (nM - fm) : WGM;
        u.pm = fm + ((wgid % nig) % gsz); u.pn = (wgid % nig) / gsz; return true;
    }
    __device__ __forceinline__ void a_ready(const Unit&) const {}
    __device__ __forceinline__ void done(const Unit&) const {}
};

__device__ __forceinline__ unsigned cvt_pk_bf16(float lo, float hi) { unsigned r; asm volatile("v_cvt_pk_bf16_f32 %0, %1, %2" : "=v"(r) : "v"(lo), "v"(hi)); return r; }
typedef float f32x2 __attribute__((ext_vector_type(2)));
__device__ __forceinline__ f32x2 gelu_pk(f32x2 v) {
    const f32x2 av = __builtin_elementwise_abs(v), d = av * 0.2316418882f + 1.0f;
    f32x2 t; t.x = __builtin_amdgcn_rcpf(d.x); t.y = __builtin_amdgcn_rcpf(d.y);
    f32x2 q = t * 0.5307027145f + (-0.7265760135f); q = q * t + 0.7107068705f; q = q * t + (-0.142248368f); q = q * t + 0.127414796f; q = q * t;
    const f32x2 s = (v * v) * (-0.72134752044f);
    f32x2 e; e.x = __builtin_amdgcn_exp2f(s.x); e.y = __builtin_amdgcn_exp2f(s.y);
    const f32x2 m = v * (q * e), r = v - m;
    f32x2 o; o.x = v.x < 0.f ? m.x : r.x; o.y = v.y < 0.f ? m.y : r.y; return o;
}

template <int ACT  > struct EpiBf16 {
    static constexpr bool PERM = true, AFTER_DRAIN = false; static_assert(ACT == 0 || ACT == 1, "EpiBf16: ACT is 0 (none) or 1 (gelu_pk)");
    bf16_t* O; int ldc; const float* bias; int split_cols; size_t split_stride; float scale0;
    __device__ __forceinline__ void operator()(const f32x4 (&acc)[2][2][4][2], const Unit& u, int wr, int wc, int fr, int fq) const {
        const int row0 = u.pm * BM + wr * 64 + fr; int colt = u.pn * BM; bf16_t* base = O;
        float sc = 1.f; if (split_cols) { const int t = colt / split_cols; base += (size_t)t * split_stride; colt -= t * split_cols; if (t == 0) sc = scale0; }
        const int col0 = colt + wc * 32 + 8 * fq, bcol0 = u.pn * BM + wc * 32 + 8 * fq;
        f32x4 bv[2][2];
#pragma unroll
        for (int bj = 0; bj < 2; ++bj)
#pragma unroll
            for (int n = 0; n < 2; ++n) bv[bj][n] = bias ? *(const f32x4*)(bias + bcol0 + bj * HALF + 4 * n) : (f32x4){0.f, 0.f, 0.f, 0.f};
#pragma unroll
        for (int ai = 0; ai < 2; ++ai)
#pragma unroll
            for (int m = 0; m < 4; ++m) { bf16_t* rowp = base + (size_t)(row0 + ai * HALF + m * 16) * ldc + col0;
#pragma unroll
                for (int bj = 0; bj < 2; ++bj) { f32x4 v0 = acc[ai][bj][m][0] + bv[bj][0], v1 = acc[ai][bj][m][1] + bv[bj][1];
                    if (ACT == 1) { f32x2 a = gelu_pk((f32x2){v0[0], v0[1]}), b = gelu_pk((f32x2){v0[2], v0[3]}), c = gelu_pk((f32x2){v1[0], v1[1]}), d = gelu_pk((f32x2){v1[2], v1[3]});
                        v0 = (f32x4){a.x, a.y, b.x, b.y}; v1 = (f32x4){c.x, c.y, d.x, d.y}; }
                    v0 = v0 * sc; v1 = v1 * sc; u32x4 w; w.x = cvt_pk_bf16(v0[0], v0[1]); w.y = cvt_pk_bf16(v0[2], v0[3]); w.z = cvt_pk_bf16(v1[0], v1[1]); w.w = cvt_pk_bf16(v1[2], v1[3]);
                    *(u32x4*)(rowp + bj * HALF) = w; } }
    }
};

struct PanelStats {
    unsigned* xbuf;
    unsigned* cnt;
    unsigned* tmo;
    int ntn; float eps;
    unsigned code;
    __device__ __forceinline__ bool run(const f32x4 (&v)[2][2][4][2], const Unit& u, int wr, int wc, int fr, int fq, PG8_LAS unsigned char* lds, int wid, int lane) const {
        typedef float f32x2v __attribute__((ext_vector_type(2)));
        PG8_LAS f32x2v* P = (PG8_LAS f32x2v*)lds;
        PG8_LAS f32x2v* S = (PG8_LAS f32x2v*)(lds + 8192);
        PG8_LAS unsigned* flag = (PG8_LAS unsigned*)(lds + 8192 + 2048);
#pragma unroll
        for (int ai = 0; ai < 2; ++ai)
#pragma unroll
            for (int m = 0; m < 4; ++m) {
                float s = 0.f;
#pragma unroll
                for (int bj = 0; bj < 2; ++bj)
#pragma unroll
                    for (int n = 0; n < 2; ++n) { const f32x4 x = v[ai][bj][m][n]; s += (x[0] + x[1]) + (x[2] + x[3]); }
                s += __shfl_xor(s, 16); s += __shfl_xor(s, 32);
                const float mw = s * (1.0f / 64.0f); float q = 0.f;
#pragma unroll
                for (int bj = 0; bj < 2; ++bj)
#pragma unroll
                    for (int n = 0; n < 2; ++n) { const f32x4 d = v[ai][bj][m][n] - mw; q += (d[0] * d[0] + d[1] * d[1]) + (d[2] * d[2] + d[3] * d[3]); }
                q += __shfl_xor(q, 16); q += __shfl_xor(q, 32);
                if (fq == 0) P[(ai * HALF + wr * 64 + m * 16 + fr) * 4 + wc] = (f32x2v){mw, q};
            }
        asm volatile("s_waitcnt lgkmcnt(0)" ::: "memory"); __builtin_amdgcn_s_barrier(); asm volatile("" ::: "memory");
#if defined(BROKEN_EXCHANGE_NO_WAIT)
#warning BROKEN CONTROL BUILD: the row-statistics exchange does not wait; results are wrong by design
        if (blockIdx.x >= 64) { const long long t0_ = clock64(); while (clock64() - t0_ < 60000) __builtin_amdgcn_s_sleep(8); }
#endif
        const int row = wid * 32 + (lane & 31);
        if (lane < 32) {
            const f32x2v a = P[row * 4 + 0], b = P[row * 4 + 1], c = P[row * 4 + 2], d = P[row * 4 + 3];
            const float mt = (a.x + b.x + c.x + d.x) * 0.25f;
            const float da = a.x - mt, db = b.x - mt, dc = c.x - mt, dd = d.x - mt;
            const float m2 = (a.y + b.y) + (c.y + d.y) + 64.0f * ((da * da + db * db) + (dc * dc + dd * dd));
            unsigned long long* slot = (unsigned long long*)xbuf + ((size_t)(u.pm * BM + row) * 4 + u.pn);
            __hip_atomic_store(slot, ((unsigned long long)__float_as_uint(m2) << 32) | __float_as_uint(mt), __ATOMIC_RELAXED, __HIP_MEMORY_SCOPE_AGENT);
        }
        asm volatile("s_waitcnt vmcnt(0)" ::: "memory");
        if (lane == 0) __hip_atomic_fetch_add(cnt + 64 * u.pm, 1u, __ATOMIC_RELAXED, __HIP_MEMORY_SCOPE_AGENT);
        if (wid == 0) {
            bool dead = false; const unsigned long long t0 = __builtin_amdgcn_s_memrealtime(); const unsigned want = 8u * (unsigned)ntn;
            for (;;) {
#if defined(BROKEN_EXCHANGE_NO_WAIT)
                break;
#endif
                if ((unsigned)__builtin_amdgcn_readfirstlane(__hip_atomic_load(cnt + 64 * u.pm, __ATOMIC_RELAXED, __HIP_MEMORY_SCOPE_AGENT)) >= want) break;
                if (__builtin_amdgcn_s_memrealtime() - t0 > 2000000ull) {
                    if (lane == 0) { unsigned expect = 0u; __hip_atomic_compare_exchange_strong(tmo + 1, &expect, code | (unsigned)(u.pm & 0xff), __ATOMIC_RELAXED, __ATOMIC_RELAXED, __HIP_MEMORY_SCOPE_AGENT);
                                     __hip_atomic_store(tmo, 1u, __ATOMIC_RELAXED, __HIP_MEMORY_SCOPE_AGENT); }
                    dead = true; break; }
                __builtin_amdgcn_s_sleep(2);
            }
            __builtin_amdgcn_fence(__ATOMIC_ACQUIRE, "agent");
            if (lane == 0) flag[0] = dead ? 1u : 0u;
        }
        asm volatile("s_waitcnt vmcnt(0) lgkmcnt(0)" ::: "memory"); __builtin_amdgcn_s_barrier(); asm volatile("" ::: "memory");
        const bool bad = flag[0] != 0u;
        if (lane < 32) {
            const unsigned long long* slot = (const unsigned long long*)xbuf + (size_t)(u.pm * BM + row) * 4; float mt[4], m2[4]; float ms = 0.f;
#pragma unroll
            for (int t = 0; t < 4; ++t) { if (t < ntn) { const unsigned long long w = __hip_atomic_load(slot + t, __ATOMIC_RELAXED, __HIP_MEMORY_SCOPE_AGENT); mt[t] = __uint_as_float((unsigned)w); m2[t] = __uint_as_float((unsigned)(w >> 32)); } else { mt[t] = 0.f; m2[t] = 0.f; } ms += mt[t]; }
            const float mean = ms / (float)ntn; float q = 0.f;
#pragma unroll
            for (int t = 0; t < 4; ++t) if (t < ntn) { const float dm = mt[t] - mean; q += m2[t] + 256.0f * dm * dm; }
            S[row] = (f32x2v){mean, 1.0f / sqrtf(q / (256.0f * (float)ntn) + eps)};
        }
        asm volatile("s_waitcnt lgkmcnt(0)" ::: "memory"); __builtin_amdgcn_s_barrier(); asm volatile("" ::: "memory");
        return bad;
    }
};
struct EpiLnRes {
    static constexpr bool PERM = false, AFTER_DRAIN = true;
    const float* base; float* out; int ldc; const float* bias; PanelStats st; unsigned poison;
    __device__ __forceinline__ void fused(f32x4 (&acc)[2][2][4][2], const Unit& u, int wr, int wc, int fr, int fq, PG8_LAS unsigned char* lds, int wid, int lane) const {
        typedef float f32x2v __attribute__((ext_vector_type(2)));
        const PG8_LAS f32x2v* S = (const PG8_LAS f32x2v*)(lds + 8192);
        const int col0 = u.pn * BM + wc * 32 + 4 * fq;
#pragma unroll
        for (int bj = 0; bj < 2; ++bj)
#pragma unroll
            for (int n = 0; n < 2; ++n) { const f32x4 bv = bias ? *(const f32x4*)(bias + col0 + bj * HALF + n * 16) : (f32x4){0.f, 0.f, 0.f, 0.f};
#pragma unroll
                for (int ai = 0; ai < 2; ++ai)
#pragma unroll
                    for (int m = 0; m < 4; ++m) acc[ai][bj][m][n] += bv; }
        f32x4 pre[4][2][2];
#pragma unroll
        for (int m = 0; m < 4; ++m) { const size_t off = (size_t)(u.pm * BM + wr * 64 + m * 16 + fr) * ldc + col0;
#pragma unroll
            for (int bj = 0; bj < 2; ++bj)
#pragma unroll
                for (int n = 0; n < 2; ++n) pre[m][bj][n] = *(const f32x4*)(base + off + bj * HALF + n * 16); }
        const bool bad = st.run(acc, u, wr, wc, fr, fq, lds, wid, lane) || poison != 0u;
        const float qnan = __builtin_nanf("");
#pragma unroll
        for (int ai = 0; ai < 2; ++ai)
#pragma unroll
            for (int m = 0; m < 4; ++m) { const int r = ai * HALF + wr * 64 + m * 16 + fr; const f32x2v sr = S[r]; const size_t off = (size_t)(u.pm * BM + r) * ldc + col0;
#pragma unroll
                for (int bj = 0; bj < 2; ++bj)
#pragma unroll
                    for (int n = 0; n < 2; ++n) { const f32x4 bs = ai == 0 ? pre[m][bj][n] : *(const f32x4*)(base + off + bj * HALF + n * 16); f32x4 o = bs + (acc[ai][bj][m][n] - sr.x) * sr.y;
                        if (bad) o = (f32x4){qnan, qnan, qnan, qnan}; *(f32x4*)(out + off + bj * HALF + n * 16) = o; }
                if (m & 1) asm volatile("" ::: "memory"); }
    }
};
struct EpiLnResLn {
    static constexpr bool PERM = false, AFTER_DRAIN = true;
    const float* base; float* out; bf16_t* xn; int ldc; const float* bias; PanelStats st1, st2; unsigned poison;
    __device__ __forceinline__ void fused(f32x4 (&acc)[2][2][4][2], const Unit& u, int wr, int wc, int fr, int fq, PG8_LAS unsigned char* lds, int wid, int lane) const {
        typedef float f32x2v __attribute__((ext_vector_type(2))); typedef unsigned u32x2v __attribute__((ext_vector_type(2)));
        const PG8_LAS f32x2v* S = (const PG8_LAS f32x2v*)(lds + 8192);
        const int col0 = u.pn * BM + wc * 32 + 4 * fq;
#pragma unroll
        for (int bj = 0; bj < 2; ++bj)
#pragma unroll
            for (int n = 0; n < 2; ++n) { const f32x4 bv = bias ? *(const f32x4*)(bias + col0 + bj * HALF + n * 16) : (f32x4){0.f, 0.f, 0.f, 0.f};
#pragma unroll
                for (int ai = 0; ai < 2; ++ai)
#pragma unroll
                    for (int m = 0; m < 4; ++m) acc[ai][bj][m][n] += bv; }
        bool bad = st1.run(acc, u, wr, wc, fr, fq, lds, wid, lane) || poison != 0u;
        const float qnan = __builtin_nanf("");
#pragma unroll
        for (int ai = 0; ai < 2; ++ai)
#pragma unroll
            for (int m = 0; m < 4; ++m) { const int r = ai * HALF + wr * 64 + m * 16 + fr; const f32x2v sr = S[r]; const size_t off = (size_t)(u.pm * BM + r) * ldc + col0;
#pragma unroll
                for (int bj = 0; bj < 2; ++bj)
#pragma unroll
                    for (int n = 0; n < 2; ++n) { const f32x4 bs = *(const f32x4*)(base + off + bj * HALF + n * 16); acc[ai][bj][m][n] = bs + (acc[ai][bj][m][n] - sr.x) * sr.y; }
                asm volatile("" : "+v"(acc[ai][0][m][0]), "+v"(acc[ai][0][m][1]), "+v"(acc[ai][1][m][0]), "+v"(acc[ai][1][m][1]));
                if (m & 1) asm volatile("" ::: "memory"); }
        const bool bad1 = bad;
        bad = st2.run(acc, u, wr, wc, fr, fq, lds, wid, lane) || bad;
#pragma unroll
        for (int ai = 0; ai < 2; ++ai)
#pragma unroll
            for (int m = 0; m < 4; ++m) { const int r = ai * HALF + wr * 64 + m * 16 + fr; const f32x2v sr = S[r]; const size_t off = (size_t)(u.pm * BM + r) * ldc + col0;
#pragma unroll
                for (int bj = 0; bj < 2; ++bj)
#pragma unroll
                    for (int n = 0; n < 2; ++n) { const f32x4 x1 = acc[ai][bj][m][n]; *(f32x4*)(out + off + bj * HALF + n * 16) = bad1 ? (f32x4){qnan, qnan, qnan, qnan} : x1;
                        const f32x4 o = (x1 - sr.x) * sr.y; u32x2v w; w.x = cvt_pk_bf16(o[0], o[1]); w.y = cvt_pk_bf16(o[2], o[3]);
                        if (bad) { w.x = 0x7fc07fc0u; w.y = 0x7fc07fc0u; } *(u32x2v*)(xn + off + bj * HALF + n * 16) = w; }
                asm volatile("" ::: "memory"); }
    }
};

template <class Epi, class Sched, bool ALIGN_EPI = false, bool SP2 = false>
__device__ __forceinline__ void gemm_phase(PG8_LAS unsigned char* lds, const Gemm g, const Sched& S, const Epi& E) {
    const int tid = threadIdx.x, wid = __builtin_amdgcn_readfirstlane(tid >> 6), lane = tid & 63, wr = wid >> 2, wc = wid & 3, fr = lane & 15, fq = lane >> 4;
    const int K = g.K, nt = K / BK;
    unsigned voffA[2], voffB[2];
#pragma unroll
    for (int i = 0; i < 2; ++i) { int R, C; stage_rc(tid * 16 + i * 8192, R, C); const int Rb = Epi::PERM ? ((R & ~31) + perm32(R & 31)) : R;
        voffA[i] = (unsigned)(R * K + C) * 2u; voffB[i] = (unsigned)(Rb * K + C) * 2u; }
    const size_t kstep = (size_t)(BK * 2);
    const size_t hstep = (size_t)HALF * K * 2;
    const size_t tstep = 2 * hstep;
    const unsigned ldsw = (unsigned)wid * 1024u;
    const int aoff = lds_byte(wr * 64 + fr, fq * 8), boff = lds_byte(wc * 32 + fr, fq * 8);
#define PG8_SA(b, h) (((b) * 2 + (h)) * HTB)
#define PG8_SB(b, h) ((4 + (b) * 2 + (h)) * HTB)
#define PG8_STAGE(bufoff, gbase, voff) do { _Pragma("unroll") for (int _i = 0; _i < 2; ++_i) \
        __builtin_amdgcn_global_load_lds((const unsigned*)((const char*)(gbase) + (voff)[_i]), (PG8_LAS unsigned*)(lds + (bufoff) + ldsw + _i * 8192), 16, 0, 0); } while (0)
#define PG8_LDA(dst, b, h) do { _Pragma("unroll") for (int m = 0; m < 4; ++m) _Pragma("unroll") for (int k = 0; k < 2; ++k) dst[m][k] = *(const PG8_LAS bf16x8*)(lds + PG8_SA(b, h) + aoff + m * 2048 + k * 1024); } while (0)
#define PG8_LDB(dst, b, h) do { _Pragma("unroll") for (int n = 0; n < 2; ++n) _Pragma("unroll") for (int k = 0; k < 2; ++k) dst[n][k] = *(const PG8_LAS bf16x8*)(lds + PG8_SB(b, h) + boff + n * 2048 + k * 1024); } while (0)
#define PG8_MMA(ai, bj, At, Bt) do { __builtin_amdgcn_s_setprio(1); _Pragma("unroll") for (int m = 0; m < 4; ++m) _Pragma("unroll") for (int n = 0; n < 2; ++n) _Pragma("unroll") for (int k = 0; k < 2; ++k) \
        acc[ai][bj][m][n] = __builtin_amdgcn_mfma_f32_16x16x32_bf16(Bt[n][k], At[m][k], acc[ai][bj][m][n], 0, 0, 0); __builtin_amdgcn_s_setprio(0); } while (0)
#define PG8_WAIT_V(n) asm volatile("s_waitcnt vmcnt(" #n ")" ::: "memory")
#define PG8_WAIT_L(n) asm volatile("s_waitcnt lgkmcnt(" #n ")" ::: "memory")
#define PG8_BAR __builtin_amdgcn_s_barrier()
#define PG8_SCHED __builtin_amdgcn_sched_barrier(0)
    Unit cur, nxt; int ui = 0;
    if (!S.next(0, cur)) return;
    f32x4 acc[2][2][4][2];
#pragma unroll
    for (int a = 0; a < 2; ++a)
#pragma unroll
        for (int b = 0; b < 2; ++b)
#pragma unroll
            for (int m = 0; m < 4; ++m)
#pragma unroll
                for (int n = 0; n < 2; ++n) acc[a][b][m][n] = (f32x4){0.f, 0.f, 0.f, 0.f};
    bf16x8 At[4][2], B0[2][2], B1[2][2];
    const char* cA = (const char*)g.A + (size_t)cur.pm * tstep; const char* cB = (const char*)g.Bt + (size_t)cur.pn * tstep;
    S.a_ready(cur);
    if constexpr (SP2) {
        PG8_STAGE(PG8_SB(0, 0), cB, voffB); PG8_STAGE(PG8_SB(0, 1), cB + hstep, voffB); PG8_STAGE(PG8_SA(0, 0), cA, voffA); PG8_STAGE(PG8_SA(0, 1), cA + hstep, voffA);
        if (wr == 1) PG8_BAR;
        PG8_WAIT_V(2); PG8_BAR;
        PG8_STAGE(PG8_SB(1, 0), cB + kstep, voffB); PG8_STAGE(PG8_SA(1, 0), cA + kstep, voffA); PG8_STAGE(PG8_SB(1, 1), cB + hstep + kstep, voffB);
        PG8_WAIT_V(6); PG8_BAR;
    } else {
        PG8_STAGE(PG8_SB(0, 0), cB, voffB); PG8_STAGE(PG8_SA(0, 0), cA, voffA); PG8_STAGE(PG8_SB(0, 1), cB + hstep, voffB); PG8_STAGE(PG8_SA(0, 1), cA + hstep, voffA);
        if (wr == 1) PG8_BAR;
        PG8_WAIT_V(4); PG8_BAR;
        PG8_STAGE(PG8_SB(1, 0), cB + kstep, voffB); PG8_STAGE(PG8_SA(1, 0), cA + kstep, voffA); PG8_STAGE(PG8_SB(1, 1), cB + hstep + kstep, voffB);
        PG8_WAIT_V(6); PG8_BAR;
    }
    for (;;) {
        const bool has_next = S.next(ui + 1, nxt);
        const char* nA = has_next ? (const char*)g.A + (size_t)nxt.pm * tstep : cA; const char* nB = has_next ? (const char*)g.Bt + (size_t)nxt.pn * tstep : cB;
        for (int t = 0; t < nt; t += 2) {
            const bool last = (t == nt - 2);
            const char* a1 = cA + (size_t)(t + 1) * kstep;
            const char* a2 = last ? nA : cA + (size_t)(t + 2) * kstep; const char* b2 = last ? nB : cB + (size_t)(t + 2) * kstep;
            const char* a3 = a2 + kstep; const char* b3 = b2 + kstep;
            if (last && has_next) S.a_ready(nxt);
            if constexpr (SP2) {
            PG8_LDB(B0, 0, 0); PG8_LDB(B1, 0, 1); PG8_SCHED; PG8_LDA(At, 0, 0); PG8_STAGE(PG8_SA(1, 1), a1 + hstep, voffA);
            PG8_WAIT_V(8); PG8_WAIT_L(0); PG8_BAR; PG8_MMA(0, 0, At, B0); PG8_MMA(0, 1, At, B1); PG8_BAR; PG8_SCHED;
            PG8_LDA(At, 0, 1); PG8_STAGE(PG8_SB(0, 0), b2, voffB); PG8_STAGE(PG8_SB(0, 1), b2 + hstep, voffB); PG8_STAGE(PG8_SA(0, 0), a2, voffA);
            PG8_WAIT_V(8); PG8_WAIT_L(0); PG8_BAR; PG8_MMA(1, 0, At, B0); PG8_MMA(1, 1, At, B1); PG8_BAR; PG8_SCHED;
            PG8_LDB(B0, 1, 0); PG8_LDB(B1, 1, 1); PG8_SCHED; PG8_LDA(At, 1, 0); PG8_STAGE(PG8_SA(0, 1), a2 + hstep, voffA);
            PG8_WAIT_V(8); PG8_WAIT_L(0); PG8_BAR; PG8_MMA(0, 0, At, B0); PG8_MMA(0, 1, At, B1); PG8_BAR; PG8_SCHED;
            PG8_LDA(At, 1, 1); PG8_STAGE(PG8_SB(1, 0), b3, voffB); PG8_STAGE(PG8_SB(1, 1), b3 + hstep, voffB); PG8_STAGE(PG8_SA(1, 0), a3, voffA);
            PG8_WAIT_V(8); PG8_WAIT_L(0); PG8_BAR; PG8_MMA(1, 0, At, B0); PG8_MMA(1, 1, At, B1); PG8_BAR; PG8_SCHED;
            } else {
            PG8_LDB(B0, 0, 0); PG8_SCHED; PG8_LDA(At, 0, 0); PG8_STAGE(PG8_SA(1, 1), a1 + hstep, voffA);
            PG8_WAIT_L(8); PG8_BAR; PG8_WAIT_L(0); PG8_MMA(0, 0, At, B0); PG8_BAR; PG8_SCHED;
            PG8_LDB(B1, 0, 1); PG8_STAGE(PG8_SB(0, 0), b2, voffB);
            PG8_BAR; PG8_WAIT_L(0); PG8_MMA(0, 1, At, B1); PG8_BAR;
            PG8_LDA(At, 0, 1); PG8_STAGE(PG8_SA(0, 0), a2, voffA);
            PG8_BAR; PG8_WAIT_L(0); PG8_MMA(1, 0, At, B0); PG8_BAR; PG8_SCHED;
            PG8_STAGE(PG8_SB(0, 1), b2 + hstep, voffB);
            PG8_WAIT_V(6); PG8_BAR; PG8_MMA(1, 1, At, B1); PG8_BAR;
            PG8_LDB(B0, 1, 0); PG8_SCHED; PG8_LDA(At, 1, 0); PG8_STAGE(PG8_SA(0, 1), a2 + hstep, voffA);
            PG8_WAIT_L(8); PG8_BAR; PG8_WAIT_L(0); PG8_MMA(0, 0, At, B0); PG8_BAR; PG8_SCHED;
            PG8_LDB(B1, 1, 1); PG8_STAGE(PG8_SB(1, 0), b3, voffB);
            PG8_BAR; PG8_WAIT_L(0); PG8_MMA(0, 1, At, B1); PG8_BAR;
            PG8_LDA(At, 1, 1); PG8_STAGE(PG8_SA(1, 0), a3, voffA);
            PG8_BAR; PG8_WAIT_L(0); PG8_MMA(1, 0, At, B0); PG8_BAR; PG8_SCHED;
            PG8_STAGE(PG8_SB(1, 1), b3 + hstep, voffB);
            PG8_WAIT_V(6); PG8_BAR; PG8_MMA(1, 1, At, B1); PG8_BAR;
            }
        }
        if constexpr (ALIGN_EPI) { if (wr == 0) PG8_BAR; }
        if constexpr (!Epi::AFTER_DRAIN) { E(acc, cur, wr, wc, fr, fq); S.done(cur); }
        if (!has_next) break;
#pragma unroll
        for (int a = 0; a < 2; ++a)
#pragma unroll
            for (int b = 0; b < 2; ++b)
#pragma unroll
                for (int m = 0; m < 4; ++m)
#pragma unroll
                    for (int n = 0; n < 2; ++n) acc[a][b][m][n] = (f32x4){0.f, 0.f, 0.f, 0.f};
        cur = nxt; cA = nA; cB = nB; ++ui;
        if constexpr (ALIGN_EPI) { if (wr == 1) PG8_BAR; }
    }
    PG8_WAIT_V(0);
    if constexpr (!ALIGN_EPI) { if (wr == 0) PG8_BAR; }
    PG8_BAR;
    if constexpr (Epi::AFTER_DRAIN) { E.fused(acc, cur, wr, wc, fr, fq, lds, wid, lane); S.done(cur); }
#undef PG8_SA
#undef PG8_SB
#undef PG8_STAGE
#undef PG8_LDA
#undef PG8_LDB
#undef PG8_MMA
#undef PG8_WAIT_V
#undef PG8_WAIT_L
#undef PG8_BAR
#undef PG8_SCHED
}
}

namespace pg8 {
struct EpiF32 {
    static constexpr bool PERM = false, AFTER_DRAIN = false;
    float* C; int ldc;
    __device__ __forceinline__ void operator()(const f32x4 (&acc)[2][2][4][2], const Unit& u, int wr, int wc, int fr, int fq) const {
        const int row0 = u.pm * BM + wr * 64 + fr, col0 = u.pn * BM + wc * 32 + 4 * fq;
#pragma unroll
        for (int ai = 0; ai < 2; ++ai)
#pragma unroll
            for (int m = 0; m < 4; ++m) { float* rowp = C + (size_t)(row0 + ai * HALF + m * 16) * ldc + col0;
#pragma unroll
                for (int bj = 0; bj < 2; ++bj)
#pragma unroll
                    for (int n = 0; n < 2; ++n) *(f32x4*)(rowp + bj * HALF + n * 16) = acc[ai][bj][m][n]; }
    }
};
struct EpiZ {
    static constexpr bool PERM = true, AFTER_DRAIN = false;
    bf16_t* Z; float* out;
    __device__ __forceinline__ void operator()(const f32x4 (&acc)[2][2][4][2], const Unit& u, int wr, int wc, int fr, int fq) const {
        const int row0 = u.pm * BM + wr * 64 + fr, col0 = u.pn * BM + wc * 32 + 8 * fq;
        const bool kvt = (u.pn >= 2 && u.pn <= 5) && (u.pm >= 56);
        float* wbase = nullptr; int kc0 = 0;
        if (kvt) { const bool isk = u.pn < 4, smp = u.pm == 64; kc0 = col0 - (isk ? 512 : 1024); size_t off = smp ? (size_t)19213828 : (size_t)17039360; if (!isk) off += smp ? (size_t)33554432 : (size_t)1048576; wbase = out + off; }
#pragma unroll
        for (int ai = 0; ai < 2; ++ai)
#pragma unroll
            for (int m = 0; m < 4; ++m) { const int row = row0 + ai * HALF + m * 16; bf16_t* rowp = Z + (size_t)row * 3584 + col0;
                size_t wrow = 0;
                if (kvt) { if (u.pm == 64) { const int sr = row - 16384; wrow = (size_t)((sr >> 3) * 2048 + 2040 + (sr & 7)); } else wrow = (size_t)(row - 14336); }
#pragma unroll
                for (int bj = 0; bj < 2; ++bj) { const f32x4 v0 = acc[ai][bj][m][0], v1 = acc[ai][bj][m][1];
                    u32x4 w; w.x = cvt_pk_bf16(v0[0], v0[1]); w.y = cvt_pk_bf16(v0[2], v0[3]); w.z = cvt_pk_bf16(v1[0], v1[1]); w.w = cvt_pk_bf16(v1[2], v1[3]);
                    *(u32x4*)(rowp + bj * HALF) = w;
                    if (kvt) { float* d = wbase + wrow * 512 + kc0 + bj * HALF; *(f32x4*)d = v0; *(f32x4*)(d + 4) = v1; } } }
    }
};
}

constexpr int NWAVES = 8;
constexpr int TP = 16384, TS = 256, MALL = TP + TS, DM = 1024, NZ = 3584, NIN = 3592, DFF = 2816, NUP = 5632;
constexpr float RMS_EPS = 1e-6f;
constexpr float LOG2E = 1.4426950408889634f;
constexpr float QSCALE = 0.125f * LOG2E;
constexpr float KMSCALE = 0.08838834764831845f;
constexpr int ZQA = 0, ZKA = 512, ZVA = 1024, ZQM = 1536, ZKM = 2048, ZVM = 2560, ZOM = 3072;
constexpr size_t O_YP = 0, O_YS = 16777216, O_KWP = 17039360, O_VWP = 18087936, O_CP = 19136512, O_NP = 19202048, O_MP = 19202560, O_CONVP = 19202564,
    O_KWS = 19213828, O_VWS = 52768260, O_CS = 86322692, O_NS = 88419844, O_MS = 88436228, O_CONVS = 88436356, O_END = 88796804;
constexpr size_t MiB = 1u << 20;
constexpr size_t WS_CTL = 0, CTL_ZERO_BYTES = 1 * MiB;
constexpr size_t WS_WIN = 2 * MiB, WS_WOUT = 10 * MiB, WS_WUP = 12 * MiB, WS_WDN = 24 * MiB;
constexpr size_t WS_G = 30 * MiB, WS_GB = 31 * MiB, WS_CS = 32 * MiB, WS_BT = 32 * MiB + 131072, WS_LSE = 33 * MiB, WS_DN = 35 * MiB, WS_NSNAP = 35 * MiB + 524288;
constexpr size_t WS_XN = 36 * MiB, WS_Z = 72 * MiB, WS_PART = 192 * MiB, WS_DC = 244 * MiB, WS_CSNAP = 278 * MiB, WS_MIX = 296 * MiB, WS_MIXED = 332 * MiB, WS_END = 402 * MiB;
constexpr size_t WS_U = 72 * MiB, WS_ACT = 296 * MiB, WS_Y = 72 * MiB;
static_assert(WS_XN + (size_t)MALL * DM * 2 <= WS_Z && WS_Z + (size_t)MALL * NZ * 2 <= WS_PART && WS_PART + (size_t)3 * TP * 512 * 2 <= WS_DC && WS_DC + (size_t)512 * 16384 * 4 <= WS_CSNAP
              && WS_CSNAP + (size_t)512 * 16384 * 2 <= WS_MIX && WS_MIX + (size_t)MALL * DM * 2 <= WS_MIXED && WS_MIXED + (size_t)MALL * DM * 4 <= WS_END
              && WS_U + (size_t)MALL * NUP * 2 <= WS_MIX && WS_ACT + (size_t)MALL * DFF * 2 <= WS_END && WS_Y + (size_t)MALL * DM * 4 <= WS_MIX, "d_ws map");
constexpr int CW_TMO = 0, CW_CODE = 1, CW_BAR = 4096;
constexpr int RING_OFF = 0, RING_BYTES = 131072, LDSCTL_OFF = RING_BYTES, MISC_OFF = LDSCTL_OFF + 320, LDS_BYTES = 147456;
constexpr int MS_OFF = 122880;

#define GAS __attribute__((address_space(1)))
#define LAS __attribute__((address_space(3)))
typedef unsigned short bf16;
typedef unsigned v4u __attribute__((ext_vector_type(4)));
typedef float f32x4 __attribute__((ext_vector_type(4)));
typedef short bf16x8 __attribute__((ext_vector_type(8)));
typedef GAS unsigned gu32;
typedef GAS unsigned long long gu64;
#define RLX_AGENT __ATOMIC_RELAXED, __HIP_MEMORY_SCOPE_AGENT
#define LDS_WAIT() asm volatile("s_waitcnt lgkmcnt(0)" ::: "memory")
#define VM_WAIT() asm volatile("s_waitcnt vmcnt(0)" ::: "memory")
__device__ __forceinline__ unsigned long long rt() { return __builtin_amdgcn_s_memrealtime(); }
__device__ __forceinline__ unsigned f2bf(float f) { unsigned u = __builtin_bit_cast(unsigned, f); return (u + 0x7fffu + ((u >> 16) & 1u)) >> 16; }
__device__ __forceinline__ unsigned pk2(float lo, float hi) { return f2bf(lo) | (f2bf(hi) << 16); }

#define XB_TMO      128
#define XB_XCNT(j)  (256  + 64 * (j))
#define XB_XSUB(j)  (1280 + 64 * (j))
#define XB_XGEN(j)  (2304 + 64 * (j))
#define XB_TOP      3328
#define XB_TOPGEN   3392
#define XCD_BAR_WORDS 3456
#define XB_SPIN_CAP (1u << 18)

__device__ __forceinline__ unsigned xb_ld(unsigned* p)              { return __hip_atomic_load(p, __ATOMIC_RELAXED, __HIP_MEMORY_SCOPE_AGENT); }
__device__ __forceinline__ unsigned xb_add(unsigned* p, unsigned v) { return __hip_atomic_fetch_add(p, v, __ATOMIC_RELAXED, __HIP_MEMORY_SCOPE_AGENT); }
__device__ __forceinline__ unsigned xb_xcc_id() { return (unsigned)__builtin_amdgcn_s_getreg((3 << 11) | 20) & 0xFu; }
#define XB_SPIN(cond, bar) do { unsigned _sp = 0; while (cond) { __builtin_amdgcn_s_sleep(1); \
    if ((++_sp & 255u) == 0u) { if (xb_ld(&(bar)[XB_TMO])) break; if (_sp > XB_SPIN_CAP) { atomicAdd(&(bar)[XB_TMO], 1u); break; } } } } while (0)

struct XcdBarrier {
    unsigned* bar; unsigned x;
    volatile LAS unsigned* st;
};

__device__ __forceinline__ XcdBarrier xcd_barrier_post(unsigned* bar, volatile LAS unsigned* st) {
    XcdBarrier b; b.bar = bar; b.x = xb_xcc_id(); b.st = st;
    if (threadIdx.x == 0) (void)xb_add(&bar[XB_XCNT(b.x)], 1u);
    return b;
}
__device__ __forceinline__ void xcd_barrier_complete(unsigned* bar, unsigned x, unsigned& nloc, unsigned& nx) {
    const unsigned G = gridDim.x * gridDim.y * gridDim.z;
    unsigned sum, cnt, mine, sp = 0u;
    for (;;) {
        sum = 0u; cnt = 0u; mine = 0u;
#pragma unroll
        for (unsigned j = 0; j < 16; ++j) { const unsigned c = xb_ld(&bar[XB_XCNT(j)]); sum += c; cnt += (c > 0u) ? 1u : 0u; mine = (j == x) ? c : mine; }
        if (sum == G) break;
        __builtin_amdgcn_s_sleep(1);
        if ((++sp & 255u) == 0u) { if (xb_ld(&bar[XB_TMO])) break; if (sp > XB_SPIN_CAP) { atomicAdd(&bar[XB_TMO], 1u); break; } }
    }
    nloc = mine > 0u ? mine : 1u; nx = cnt > 0u ? cnt : 1u;
}

__device__ __forceinline__ void xcd_barrier(const XcdBarrier& b) {
    asm volatile("s_waitcnt vmcnt(0)" ::: "memory");
    __syncthreads();
    if (threadIdx.x == 0) {
        unsigned* bar = b.bar;
        __builtin_amdgcn_s_waitcnt(0);
        unsigned nloc = b.st[0], nx = b.st[1];
        if (nloc == 0u) { xcd_barrier_complete(bar, b.x, nloc, nx); b.st[0] = nloc; b.st[1] = nx; }
        const unsigned old = xb_add(&bar[XB_XSUB(b.x)], 1u);
        const unsigned gen = old / nloc;
        if (old + 1u == (gen + 1u) * nloc) {
            __builtin_amdgcn_fence(__ATOMIC_RELEASE, "agent");
            asm volatile("s_waitcnt vmcnt(0)" ::: "memory");
            const unsigned og = xb_add(&bar[XB_TOP], 1u);
            const unsigned tg = og / nx;
            if (og + 1u == (tg + 1u) * nx) xb_add(&bar[XB_TOPGEN], 1u);
            else XB_SPIN(xb_ld(&bar[XB_TOPGEN]) == tg, bar);
            __builtin_amdgcn_fence(__ATOMIC_ACQUIRE, "agent");
            xb_add(&bar[XB_XGEN(b.x)], 1u);
            asm volatile("s_waitcnt vmcnt(0)" ::: "memory");
        } else {
            XB_SPIN(xb_ld(&bar[XB_XGEN(b.x)]) == gen, bar);
            __builtin_amdgcn_fence(__ATOMIC_ACQUIRE, "agent");
            asm volatile("s_waitcnt vmcnt(0)" ::: "memory");
        }
    }
    __syncthreads();
}


typedef short s16x4 __attribute__((ext_vector_type(4)));
typedef unsigned v2u __attribute__((ext_vector_type(2)));
typedef float f32x2 __attribute__((ext_vector_type(2)));
__device__ __forceinline__ float bf2f(unsigned short b) { return __uint_as_float((unsigned)b << 16); }
__device__ __forceinline__ float bflo(unsigned w) { return __uint_as_float(w << 16); }
__device__ __forceinline__ float bfhi(unsigned w) { return __uint_as_float(w & 0xffff0000u); }
__device__ __forceinline__ float ex2(float x) { return __builtin_amdgcn_exp2f(x); }
__device__ __forceinline__ float fexp(float x) { return __builtin_amdgcn_exp2f(x * LOG2E); }
__device__ __forceinline__ s16x4 tr_read(const LAS unsigned char* p) {
    typedef short v4i16_t __attribute__((ext_vector_type(4)));
    return __builtin_bit_cast(s16x4, __builtin_amdgcn_ds_read_tr16_b64_v4i16((LAS v4i16_t*)p)); }
__device__ __forceinline__ bf16x8 cat4(s16x4 lo, s16x4 hi) { return (bf16x8){lo[0], lo[1], lo[2], lo[3], hi[0], hi[1], hi[2], hi[3]}; }
__device__ __forceinline__ bf16x8 pack8(f32x4 a, f32x4 b) {
    v4u w; w.x = pk2(a[0], a[1]); w.y = pk2(a[2], a[3]); w.z = pk2(b[0], b[1]); w.w = pk2(b[2], b[3]); return __builtin_bit_cast(bf16x8, w); }
#define MFMA16(a, b, c) __builtin_amdgcn_mfma_f32_16x16x32_bf16((a), (b), (c), 0, 0, 0)

struct Frame {
    LAS unsigned char* lds;
    volatile LAS unsigned* MISC;
    gu32* ctl;
    int tid, lane, wave, vcu, G;
    const float *xp, *xs, *cache_k, *cache_v, *st_C, *st_n, *st_m, *st_conv, *rel_bias, *g_pre, *w_in, *b_i, *b_f, *g_ml, *w_out, *g_post, *g_ffn, *w_up, *conv_w, *conv_b, *w_down, *g_fpost;
    float* out;
    bf16 *Win_t, *Wout_t, *Wup_t, *Wdn_t, *XN, *Z, *PART, *CSNAP, *MIX, *U, *ACT;
    float *Gt, *GB, *CS, *BT, *LSE, *DN, *NSNAP, *DC, *MIXED, *Y;
};

__device__ __forceinline__ float wave_sum(float v) {
#pragma unroll
    for (int o = 1; o < 64; o <<= 1) v += __shfl_xor(v, o);
    return v;
}

__device__ __forceinline__ void p0_transpose_item(const float* W, int ldw, int Kd, bf16* WT, LAS float* scr, int k0, int n0, int drow0, float scale, int lane) {
#pragma unroll 8
    for (int i = 0; i < 32; ++i) { const int kk = 2 * i + (lane >> 5); scr[kk * 33 + (lane & 31)] = W[(size_t)(k0 + kk) * ldw + n0 + (lane & 31)] * scale; }
    LDS_WAIT(); asm volatile("" ::: "memory");
    const int c = lane & 7;
#pragma unroll
    for (int j = 0; j < 4; ++j) { const int n = (lane >> 3) + 8 * j; const LAS float* s = scr + (8 * c) * 33 + n;
        v4u o; o.x = pk2(s[0 * 33], s[1 * 33]); o.y = pk2(s[2 * 33], s[3 * 33]); o.z = pk2(s[4 * 33], s[5 * 33]); o.w = pk2(s[6 * 33], s[7 * 33]);
        *(GAS v4u*)(WT + (size_t)(drow0 + n) * Kd + k0 + 8 * c) = o; }
    LDS_WAIT(); asm volatile("" ::: "memory");
}
__device__ __forceinline__ float logsigmoidf(float x) { return fminf(x, 0.f) - log1pf(__expf(-fabsf(x))); }

__device__ __forceinline__ void p0_prologue(Frame& F) {
    const int gw = F.vcu * NWAVES + F.wave, NGW = F.G * NWAVES, lane = F.lane;
    {
        LAS float* Wg = (LAS float*)(F.lds);
        for (int i = F.tid; i < 8192; i += NWAVES * 64) { const int j = i >> 10, k = i & 1023; Wg[i] = F.g_pre[k] * F.w_in[(size_t)k * NIN + 3584 + j]; }
        __syncthreads();
        f32x4 gp[4];
#pragma unroll
        for (int j = 0; j < 4; ++j) gp[j] = *(const f32x4*)(F.g_pre + 256 * j + 4 * lane);
        for (int m = gw; m < MALL; m += NGW) {
            const float* xrow = m < TP ? F.xp + (size_t)m * DM : F.xs + (size_t)(m - TP) * DM;
            f32x4 v[4]; float s = 0.f;
#pragma unroll
            for (int j = 0; j < 4; ++j) { v[j] = *(const f32x4*)(xrow + 256 * j + 4 * lane); s += (v[j].x * v[j].x + v[j].y * v[j].y) + (v[j].z * v[j].z + v[j].w * v[j].w); }
            const float rs = rsqrtf(wave_sum(s) * (1.f / DM) + RMS_EPS);
            float ga[8];
#pragma unroll
            for (int i = 0; i < 8; ++i) { float a = 0.f;
#pragma unroll
                for (int j = 0; j < 4; ++j) { const f32x4 w = *(const LAS f32x4*)(Wg + i * 1024 + 256 * j + 4 * lane); a += (v[j].x * w.x + v[j].y * w.y) + (v[j].z * w.z + v[j].w * w.w); }
                ga[i] = wave_sum(a) * rs; }
            if (lane == 0) {
                f32x4 o0, o1;
#pragma unroll
                for (int i = 0; i < 4; ++i) { o0[i] = ga[i] + F.b_i[i]; o1[i] = logsigmoidf(ga[4 + i] + F.b_f[i]); }
                *(f32x4*)(F.Gt + (size_t)m * 8) = o0; *(f32x4*)(F.Gt + (size_t)m * 8 + 4) = o1;
            }
            bf16* orow = F.XN + (size_t)m * DM;
#pragma unroll
            for (int j = 0; j < 4; ++j) { v2u o; o.x = pk2(v[j].x * rs * gp[j].x, v[j].y * rs * gp[j].y); o.y = pk2(v[j].z * rs * gp[j].z, v[j].w * rs * gp[j].w); *(v2u*)(orow + 256 * j + 4 * lane) = o; }
        }
        __syncthreads();
    }
    {
        LAS float* scr = (LAS float*)(F.lds + RING_OFF + F.wave * 16384);
        constexpr int I_IN = 16 * 112, I_OUT = 16 * 32, I_UP = 16 * 176, I_DN = 44 * 32, NITEMS = I_IN + I_OUT + I_UP + I_DN;
        for (int it = gw; it < NITEMS; it += NGW) {
            int r = it;
            if (r < I_IN) { const int kb = r / 112, nb = r % 112, n0 = 32 * nb; const float sc = n0 < 512 ? QSCALE : ((n0 >= ZKM && n0 < ZVM) ? KMSCALE : 1.f);
                p0_transpose_item(F.w_in, NIN, DM, F.Win_t, scr, 64 * kb, n0, n0, sc, lane); continue; } r -= I_IN;
            if (r < I_OUT) { const int kb = r / 32, nb = r % 32; p0_transpose_item(F.w_out, DM, DM, F.Wout_t, scr, 64 * kb, 32 * nb, 32 * nb, 1.f, lane); continue; } r -= I_OUT;
            if (r < I_UP) { const int kb = r / 176, nb = r % 176, n0 = 32 * nb; const int nn = n0 < DFF ? n0 : n0 - DFF; const int drow = 256 * (nn >> 7) + (nn & 127) + (n0 < DFF ? 0 : 128);
                p0_transpose_item(F.w_up, NUP, DM, F.Wup_t, scr, 64 * kb, n0, drow, 1.f, lane); continue; } r -= I_UP;
            { const int kb = r / 32, nb = r % 32; p0_transpose_item(F.w_down, DM, DFF, F.Wdn_t, scr, 64 * kb, 32 * nb, 32 * nb, 1.f, lane); }
        }
    }
    {
        constexpr size_t SEG = (size_t)2040 * 512 / 4;
        const size_t gt = (size_t)F.vcu * (NWAVES * 64) + F.tid, NT = (size_t)F.G * (NWAVES * 64);
        for (size_t i = gt; i < SEG * 64; i += NT) {
            const size_t seg = i / SEG, off = i % SEG; const int b = (int)(seg & 31); const bool isv = seg >= 32;
            const f32x4* src = (const f32x4*)((isv ? F.cache_v : F.cache_k) + (size_t)b * 2048 * 512 + 8 * 512) + off;
            f32x4* dst = (f32x4*)(F.out + (isv ? O_VWS : O_KWS) + (size_t)b * 2048 * 512) + off;
            *dst = *src;
        }
    }
    if (F.vcu == 0) {
        for (int i = F.tid; i < 3 * 8 * 132; i += NWAVES * 64) {
            const int g = i / (8 * 132), h = (i / 132) % 8, j = i % 132; float val = 0.f;
            if (j <= 128) { const int dist = j << (2 * g); int bk;
                if (dist < 16) bk = dist; else { bk = 16 + (int)(logf((float)dist * (1.f / 16.f)) / logf(128.f) * 16.f); if (bk > 31) bk = 31; }
                val = F.rel_bias[bk * 8 + h] * LOG2E; }
            F.BT[i] = val;
        }
    }
}

__device__ __forceinline__ void chunk_stats(Frame& F) {
    LAS float* sc = (LAS float*)F.lds;
    for (int c = F.vcu; c < 128; c += F.G) {
        const int h = F.tid >> 7, s = F.tid & 127; const size_t row = (size_t)128 * c + s;
        const float lf = F.Gt[row * 8 + 4 + h], ig = F.Gt[row * 8 + h];
        sc[F.tid] = lf; __syncthreads();
        int cur = 0;
        for (int off = 1; off < 128; off <<= 1) { float v = sc[cur * 512 + F.tid]; if (s >= off) v += sc[cur * 512 + F.tid - off]; sc[(cur ^ 1) * 512 + F.tid] = v; __syncthreads(); cur ^= 1; }
        const float b = sc[cur * 512 + F.tid], u = ig - b;
        F.GB[row * 8 + h] = b; F.GB[row * 8 + 4 + h] = u;
        __syncthreads();
        sc[F.tid] = u; __syncthreads();
        for (int off = 64; off >= 1; off >>= 1) { if (s < off) sc[F.tid] = fmaxf(sc[F.tid], sc[F.tid + off]); __syncthreads(); }
        if (s == 127) F.CS[(c * 4 + h) * 2] = b;
        if (s == 0) F.CS[(c * 4 + h) * 2 + 1] = sc[F.tid];
        __syncthreads();
    }
}
__device__ __forceinline__ void mscan_to_lds(Frame& F, LAS float* ms) {
    if (F.wave < 4) {
        const int h = F.wave, l = F.lane;
        const float A0 = F.CS[((2 * l) * 4 + h) * 2], B0 = A0 + F.CS[((2 * l) * 4 + h) * 2 + 1];
        const float A1 = F.CS[((2 * l + 1) * 4 + h) * 2], B1 = A1 + F.CS[((2 * l + 1) * 4 + h) * 2 + 1];
        float PA = A0 + A1, PB = fmaxf(B0 + A1, B1);
#pragma unroll
        for (int off = 1; off < 64; off <<= 1) { const float a = __shfl_up(PA, off), b = __shfl_up(PB, off); if (l >= off) { PB = fmaxf(b + PA, PB); PA = a + PA; } }
        float EA = __shfl_up(PA, 1), EB = __shfl_up(PB, 1); if (l == 0) { EA = 0.f; EB = -INFINITY; }
        const float m0 = fmaxf(EA, EB), m1 = fmaxf(m0 + A0, B0);
        ms[h * 132 + 2 * l] = m0; ms[h * 132 + 2 * l + 1] = m1;
        if (l == 63) ms[h * 132 + 128] = fmaxf(m1 + A1, B1);
    }
    __syncthreads();
}

__device__ __forceinline__ void attn_unit(Frame& F, int a) {
    const int h = a & 7, rn = (a >> 3) & 127, g = a >> 10, sh = 2 * g, nb = 128 >> sh, r = rn >> (7 - sh), n = rn & (nb - 1);
    LAS unsigned char* KT = F.lds; LAS unsigned char* VT = F.lds + 40960; LAS float* BTl = (LAS float*)(F.lds + 81920);
    const bf16* Z = F.Z;
#pragma unroll
    for (int i = 0; i < 4; ++i) {
        const int c = F.tid + 512 * i, row = c >> 3, ch = c & 7, mk = 128 * (n - 1) + row;
        v4u kk = {0u, 0u, 0u, 0u}, vv = {0u, 0u, 0u, 0u};
        if (mk >= 0) { const size_t tok = ((size_t)mk << sh) + r; const bf16* p = Z + tok * NZ + h * 64 + ch * 8; kk = *(const v4u*)(p + ZKA); vv = *(const v4u*)(p + ZVA); }
        *(LAS v4u*)(KT + row * 160 + ch * 16) = kk; *(LAS v4u*)(VT + row * 160 + ch * 16) = vv;
    }
    if (F.tid < 192) { const int st = F.tid - 32; BTl[F.tid] = (st >= 0 && st <= 128) ? F.BT[(g * 8 + h) * 132 + st] : -1e30f; }
    __syncthreads();
    const int w = F.wave, lane = F.lane, q = lane & 15, G = lane >> 4, b0 = w < 7 ? w : 6, qi = 16 * w + q;
    const size_t qtok = ((size_t)(128 * n + qi) << sh) + r;
    const bf16x8 qf0 = *(const bf16x8*)(Z + qtok * NZ + h * 64 + G * 8), qf1 = *(const bf16x8*)(Z + qtok * NZ + h * 64 + 32 + G * 8);
    f32x4 s[10];
#pragma unroll
    for (int blk = 0; blk < 10; ++blk) {
        const LAS unsigned char* kp = KT + (16 * (b0 + blk) + q) * 160 + G * 16;
        const bf16x8 k0 = *(const LAS bf16x8*)kp, k1 = *(const LAS bf16x8*)(kp + 64);
        f32x4 z = {0.f, 0.f, 0.f, 0.f};
        z = MFMA16(k0, qf0, z); s[blk] = MFMA16(k1, qf1, z);
    }
    const int base = 128 + qi - 16 * b0 - 4 * G + 32;
    float mx = -3e38f;
#pragma unroll
    for (int blk = 0; blk < 10; ++blk)
#pragma unroll
        for (int rg = 0; rg < 4; ++rg) {
            float sv = s[blk][rg] + BTl[base - 16 * blk - rg];
            if (n == 0 && (16 * (b0 + blk) + 4 * G + rg) < 128) sv = -1e30f;
            s[blk][rg] = sv; mx = fmaxf(mx, sv); }
    mx = fmaxf(mx, __shfl_xor(mx, 16)); mx = fmaxf(mx, __shfl_xor(mx, 32));
    float l = 0.f;
#pragma unroll
    for (int blk = 0; blk < 10; ++blk)
#pragma unroll
        for (int rg = 0; rg < 4; ++rg) { const float p = ex2(s[blk][rg] - mx); s[blk][rg] = p; l += p; }
    l += __shfl_xor(l, 16); l += __shfl_xor(l, 32);
    f32x4 o[4];
#pragma unroll
    for (int eb = 0; eb < 4; ++eb) o[eb] = (f32x4){0.f, 0.f, 0.f, 0.f};
    const int q4 = q >> 2, p4 = q & 3;
#pragma unroll
    for (int st = 0; st < 5; ++st) {
        const bf16x8 pb = pack8(s[2 * st], s[2 * st + 1]);
        const LAS unsigned char* vb = VT + (16 * (b0 + 2 * st) + 4 * G + q4) * 160 + 8 * p4;
#pragma unroll
        for (int eb = 0; eb < 4; ++eb) { const s16x4 lo = tr_read(vb + 32 * eb), hi = tr_read(vb + 32 * eb + 16 * 160); o[eb] = MFMA16(cat4(lo, hi), pb, o[eb]); }
    }
    const float inv = 1.f / l;
    bf16* P = F.PART + ((size_t)g * TP + qtok) * 512 + h * 64 + 4 * G;
#pragma unroll
    for (int eb = 0; eb < 4; ++eb) { v2u ov; ov.x = pk2(o[eb][0] * inv, o[eb][1] * inv); ov.y = pk2(o[eb][2] * inv, o[eb][3] * inv); *(v2u*)(P + 16 * eb) = ov; }
    if (G == 0) F.LSE[((size_t)g * TP + qtok) * 8 + h] = mx + __log2f(l);
    __syncthreads();
}

__device__ __forceinline__ void dc_unit(Frame& F, int cu, const LAS float* ms) {
    const int c = cu >> 2, h = cu & 3;
    LAS unsigned char* KT = F.lds; LAS unsigned char* VT = F.lds + 36864; LAS float* WSl = (LAS float*)(F.lds + 73728); LAS float* RED = WSl + 128;
    const float bL = F.CS[(c * 4 + h) * 2], mnext = ms[h * 132 + c + 1];
    if (F.tid < 128) WSl[F.tid] = fexp(bL + F.GB[((size_t)128 * c + F.tid) * 8 + 4 + h] - mnext);
    __syncthreads();
#pragma unroll
    for (int i = 0; i < 4; ++i) {
        const int ci = F.tid + 512 * i, row = ci >> 4, ch = ci & 15; const bf16* p = F.Z + ((size_t)128 * c + row) * NZ + 128 * h + ch * 8;
        const v4u kk = *(const v4u*)(p + ZKM), vv = *(const v4u*)(p + ZVM); const float wsv = WSl[row];
        v4u vo; vo.x = pk2(bflo(vv.x) * wsv, bfhi(vv.x) * wsv); vo.y = pk2(bflo(vv.y) * wsv, bfhi(vv.y) * wsv); vo.z = pk2(bflo(vv.z) * wsv, bfhi(vv.z) * wsv); vo.w = pk2(bflo(vv.w) * wsv, bfhi(vv.w) * wsv);
        *(LAS v4u*)(KT + row * 288 + ch * 16) = kk; *(LAS v4u*)(VT + row * 288 + ch * 16) = vo;
    }
    __syncthreads();
    const int w = F.wave, lane = F.lane, col = lane & 15, G = lane >> 4, q4 = col >> 2, p4 = col & 3;
    f32x4 acc[8];
#pragma unroll
    for (int kb = 0; kb < 8; ++kb) acc[kb] = (f32x4){0.f, 0.f, 0.f, 0.f};
#pragma unroll
    for (int ks = 0; ks < 4; ++ks) {
        const int srow = 32 * ks + 8 * G + q4;
        const LAS unsigned char* ap = VT + srow * 288 + (16 * w + 4 * p4) * 2;
        const bf16x8 A = cat4(tr_read(ap), tr_read(ap + 4 * 288));
        const LAS unsigned char* bp = KT + srow * 288 + 8 * p4;
#pragma unroll
        for (int kb = 0; kb < 8; ++kb) { const bf16x8 B = cat4(tr_read(bp + 32 * kb), tr_read(bp + 32 * kb + 4 * 288)); acc[kb] = MFMA16(A, B, acc[kb]); }
    }
    float* D = F.DC + ((size_t)(c * 4 + h) << 14);
#pragma unroll
    for (int kb = 0; kb < 8; ++kb)
#pragma unroll
        for (int rg = 0; rg < 4; ++rg) D[(16 * w + 4 * G + rg) * 128 + 16 * kb + col] = acc[kb][rg];
    { const int k = F.tid & 127, part = F.tid >> 7; float sm = 0.f;
#pragma unroll 8
      for (int s = 0; s < 32; ++s) sm += WSl[32 * part + s] * bf2f(*(const LAS unsigned short*)(KT + (32 * part + s) * 288 + k * 2));
      RED[part * 128 + k] = sm; }
    __syncthreads();
    if (F.tid < 128) F.DN[(c * 4 + h) * 128 + F.tid] = (RED[F.tid] + RED[128 + F.tid]) + (RED[256 + F.tid] + RED[384 + F.tid]);
    __syncthreads();
}

__device__ __forceinline__ void sattn_unit(Frame& F, int u) {
    const int b = u >> 3, h = u & 7, t = F.wave, lane = F.lane, sub = lane >> 4, dq = lane & 15;
    const size_t row = (size_t)TP + 8 * b + t;
    const v2u qw = *(const v2u*)(F.Z + row * NZ + h * 64 + 4 * dq);
    const f32x4 q4 = {bflo(qw.x), bfhi(qw.x), bflo(qw.y), bfhi(qw.y)};
    const float* ck = F.cache_k + ((size_t)b * 2048 * 8 + h) * 64 + 4 * dq; const float* cv = F.cache_v + ((size_t)b * 2048 * 8 + h) * 64 + 4 * dq;
    const float* nk = F.out + O_KWS + (((size_t)b * 2048 + 2040) * 8 + h) * 64 + 4 * dq; const float* nv = F.out + O_VWS + (((size_t)b * 2048 + 2040) * 8 + h) * 64 + 4 * dq;
    float mx = -3e38f, l = 0.f; f32x4 o = {0.f, 0.f, 0.f, 0.f};
    for (int g = 0; g < 3; ++g) {
        const float* bt = F.BT + (g * 8 + h) * 132;
#pragma unroll 3
        for (int it = 0; it < 33; ++it) {
            const int j = 4 * it + sub, jc = j > 128 ? 128 : j, idx = 2048 + t - (jc << (2 * g));
            const float* kp = idx < 2048 ? ck + (size_t)idx * 512 : nk + (size_t)(idx - 2048) * 512;
            const float* vp = idx < 2048 ? cv + (size_t)idx * 512 : nv + (size_t)(idx - 2048) * 512;
            const f32x4 k4 = *(const f32x4*)kp, v4 = *(const f32x4*)vp;
            float d = (q4.x * k4.x + q4.y * k4.y) + (q4.z * k4.z + q4.w * k4.w);
            d += __shfl_xor(d, 1); d += __shfl_xor(d, 2); d += __shfl_xor(d, 4); d += __shfl_xor(d, 8);
            const float sv = (j <= 128) ? d + bt[jc] : -1e30f;
            const float mn = fmaxf(mx, sv), scl = ex2(mx - mn), p = ex2(sv - mn);
            l = l * scl + p; o = o * scl + v4 * p; mx = mn;
        }
    }
    float M = fmaxf(mx, __shfl_xor(mx, 16)); M = fmaxf(M, __shfl_xor(M, 32));
    const float f = ex2(mx - M); l *= f; o = o * f;
    l += __shfl_xor(l, 16); l += __shfl_xor(l, 32);
#pragma unroll
    for (int e = 0; e < 4; ++e) { o[e] += __shfl_xor(o[e], 16); o[e] += __shfl_xor(o[e], 32); }
    if (sub == 0) { const float inv = 1.f / l; v2u ov; ov.x = pk2(o.x * inv, o.y * inv); ov.y = pk2(o.z * inv, o.w * inv); *(v2u*)(F.MIX + row * DM + h * 64 + 4 * dq) = ov; }
}

__device__ __forceinline__ void smlstm_unit(Frame& F, int u) {
    const int b = u >> 2, h = u & 3, tid = F.tid, lane = F.lane, w = F.wave;
    LAS float* QS = (LAS float*)F.lds; LAS float* KS = QS + 1024; LAS float* VS = KS + 1024; LAS float* RED = VS + 1024;
    LAS float* SS = RED + 4096;
    LAS float* QN = SS + 64;
    const size_t r0 = (size_t)TP + 8 * b;
#pragma unroll
    for (int i = 0; i < 2; ++i) { const int idx = tid + 512 * i, t = idx >> 7, d = idx & 127; const bf16* p = F.Z + (r0 + t) * NZ + 128 * h + d;
        QS[idx] = bf2f(p[ZQM]); KS[idx] = bf2f(p[ZKM]); VS[idx] = bf2f(p[ZVM]); }
    float bt[8], it_[8];
    { float cs = 0.f;
#pragma unroll
      for (int t = 0; t < 8; ++t) { cs += F.Gt[(r0 + t) * 8 + 4 + h]; bt[t] = cs; it_[t] = F.Gt[(r0 + t) * 8 + h]; } }
    const float m0 = F.st_m[b * 4 + h], bL = bt[7];
    float mnew = bL + m0;
#pragma unroll
    for (int s = 0; s < 8; ++s) mnew = fmaxf(mnew, bL - bt[s] + it_[s]);
    float wsv[8];
#pragma unroll
    for (int s = 0; s < 8; ++s) wsv[s] = fexp(bL - bt[s] + it_[s] - mnew);
    const float wc = fexp(bL + m0 - mnew);
    __syncthreads();
    { const int pair = tid >> 3, part = tid & 7, t = pair >> 3, s = pair & 7; float d = 0.f;
#pragma unroll
      for (int k = 0; k < 16; ++k) d += QS[t * 128 + 16 * part + k] * KS[s * 128 + 16 * part + k];
      d += __shfl_xor(d, 1); d += __shfl_xor(d, 2); d += __shfl_xor(d, 4);
      if (part == 0) SS[pair] = d; }
    { const float* n0 = F.st_n + (size_t)(b * 4 + h) * 128; float d = QS[w * 128 + lane] * n0[lane] + QS[w * 128 + 64 + lane] * n0[64 + lane]; d = wave_sum(d); if (lane == 0) QN[w] = d; }
    const int v = tid & 127, kq = tid >> 7;
    const float* C0 = F.st_C + ((size_t)(b * 4 + h) * 128 + 32 * kq) * 128 + v;
    float* Cn = F.out + O_CS + ((size_t)(b * 4 + h) * 128 + 32 * kq) * 128 + v;
    float pq[8];
#pragma unroll
    for (int t = 0; t < 8; ++t) pq[t] = 0.f;
    float vsw[8];
#pragma unroll
    for (int s = 0; s < 8; ++s) vsw[s] = VS[s * 128 + v] * wsv[s];
#pragma unroll 4
    for (int j = 0; j < 32; ++j) {
        const float cr = C0[(size_t)j * 128]; const int k = 32 * kq + j;
        float cn = wc * cr;
#pragma unroll
        for (int t = 0; t < 8; ++t) { pq[t] += QS[t * 128 + k] * cr; cn += KS[t * 128 + k] * vsw[t]; }
        Cn[(size_t)j * 128] = cn;
    }
#pragma unroll
    for (int t = 0; t < 8; ++t) RED[(kq * 8 + t) * 128 + v] = pq[t];
    if (tid < 128) { float nn = wc * F.st_n[(size_t)(b * 4 + h) * 128 + tid];
#pragma unroll
        for (int s = 0; s < 8; ++s) nn += wsv[s] * KS[s * 128 + tid];
        F.out[O_NS + (size_t)(b * 4 + h) * 128 + tid] = nn; }
    if (tid == 0) F.out[O_MS + b * 4 + h] = mnew;
    __syncthreads();
    {
        const int t = w; float mt = bt[0] * 0.f;
        float btt = 0.f;
#pragma unroll
        for (int s = 0; s < 8; ++s) if (s == t) btt = bt[s];
        mt = btt + m0;
#pragma unroll
        for (int s = 0; s < 8; ++s) if (s <= t) mt = fmaxf(mt, btt - bt[s] + it_[s]);
        float num0 = 0.f, num1 = 0.f, den = 0.f;
#pragma unroll
        for (int s = 0; s < 8; ++s) if (s <= t) { const float sm = SS[t * 8 + s] * fexp(btt - bt[s] + it_[s] - mt); den += sm; num0 += sm * VS[s * 128 + lane]; num1 += sm * VS[s * 128 + 64 + lane]; }
        const float iw = fexp(btt + m0 - mt);
        float c0 = 0.f, c1 = 0.f;
#pragma unroll
        for (int kq2 = 0; kq2 < 4; ++kq2) { c0 += RED[(kq2 * 8 + t) * 128 + lane]; c1 += RED[(kq2 * 8 + t) * 128 + 64 + lane]; }
        num0 += iw * c0; num1 += iw * c1; den += iw * QN[t];
        const float inv = 1.f / fmaxf(fabsf(den), fexp(-mt));
        const float h0 = num0 * inv, h1 = num1 * inv;
        const float rs = rsqrtf(wave_sum(h0 * h0 + h1 * h1) * (1.f / 128.f) + RMS_EPS);
        const bf16* om = F.Z + (r0 + t) * NZ + ZOM + 128 * h;
        const float o0 = bf2f(om[lane]), o1 = bf2f(om[64 + lane]);
        bf16* mo = F.MIX + (r0 + t) * DM + 512 + 128 * h;
        mo[lane] = (bf16)f2bf(h0 * rs * F.g_ml[128 * h + lane] / (1.f + __expf(-o0)));
        mo[64 + lane] = (bf16)f2bf(h1 * rs * F.g_ml[128 * h + 64 + lane] / (1.f + __expf(-o1)));
    }
    __syncthreads();
}

__device__ __forceinline__ void p3_scan(Frame& F) {
    LAS float* ms = (LAS float*)(F.lds + MS_OFF);
    LAS float* WC = (LAS float*)F.lds;
    mscan_to_lds(F, ms);
    { const int h = F.tid >> 7, c = F.tid & 127; WC[F.tid] = fexp(F.CS[(c * 4 + h) * 2] + ms[h * 132 + c] - ms[h * 132 + c + 1]); }
    __syncthreads();
    const int gid = F.vcu * (NWAVES * 64) + F.tid;
    if (gid < 65536) {
        const int h = gid >> 14, e = gid & 16383; float C = 0.f;
#pragma unroll 8
        for (int c = 0; c < 128; ++c) { const size_t o = ((size_t)(c * 4 + h) << 14) + e; F.CSNAP[o] = (bf16)f2bf(C); C = WC[h * 128 + c] * C + F.DC[o]; }
        const int v = e >> 7, k = e & 127; F.out[O_CP + (size_t)h * 16384 + k * 128 + v] = C;
    } else if (gid < 65536 + 512) {
        const int j = gid - 65536, h = j >> 7, k = j & 127; float nn = 0.f;
#pragma unroll 8
        for (int c = 0; c < 128; ++c) { const size_t o = (size_t)(c * 4 + h) * 128 + k; F.NSNAP[o] = nn; nn = WC[h * 128 + c] * nn + F.DN[o]; }
        F.out[O_NP + h * 128 + k] = nn;
    } else if (gid < 65536 + 512 + 4) { const int h = gid - 65536 - 512; F.out[O_MP + h] = ms[h * 132 + 128]; }
    __syncthreads();
}

__device__ __forceinline__ void mout_unit(Frame& F, int cu, const LAS float* ms) {
    const int c = cu >> 2, h = cu & 3, tid = F.tid;
    LAS unsigned char* VT = F.lds; LAS float* Ul = (LAS float*)(F.lds + 36864); LAS float* Al = Ul + 128; LAS float* Sc = Al + 128;
    const float mc = ms[h * 132 + c];
#pragma unroll
    for (int i = 0; i < 4; ++i) { const int ci = tid + 512 * i, row = ci >> 4, ch = ci & 15;
        *(LAS v4u*)(VT + row * 288 + ch * 16) = *(const v4u*)(F.Z + ((size_t)128 * c + row) * NZ + ZVM + 128 * h + ch * 8); }
    if (tid < 128) { const float u = F.GB[((size_t)128 * c + tid) * 8 + 4 + h]; Ul[tid] = u; Sc[tid] = u; }
    __syncthreads();
    int cur = 0;
    for (int off = 1; off < 128; off <<= 1) { if (tid < 128) { float v = Sc[cur * 128 + tid]; if (tid >= off) v = fmaxf(v, Sc[cur * 128 + tid - off]); Sc[(cur ^ 1) * 128 + tid] = v; } __syncthreads(); cur ^= 1; }
    if (tid < 128) Al[tid] = fmaxf(mc, Sc[cur * 128 + tid]);
    __syncthreads();
    const int w = F.wave, lane = F.lane, col = lane & 15, G = lane >> 4, q4 = col >> 2, p4 = col & 3;
    const int t = 16 * w + col; const size_t row = (size_t)128 * c + t;
    bf16x8 qf[4];
#pragma unroll
    for (int ks = 0; ks < 4; ++ks) qf[ks] = *(const bf16x8*)(F.Z + row * NZ + ZQM + 128 * h + 32 * ks + 8 * G);
    const float at = Al[t], btv = F.GB[row * 8 + h];
    f32x4 s[8];
#pragma unroll
    for (int sb = 0; sb < 8; ++sb) {
        s[sb] = (f32x4){0.f, 0.f, 0.f, 0.f};
        if (sb <= w) {
            const bf16* kp = F.Z + ((size_t)128 * c + 16 * sb + col) * NZ + ZKM + 128 * h + 8 * G;
#pragma unroll
            for (int ks = 0; ks < 4; ++ks) s[sb] = MFMA16(*(const bf16x8*)(kp + 32 * ks), qf[ks], s[sb]);
        }
    }
    float dl = 0.f;
#pragma unroll
    for (int sb = 0; sb < 8; ++sb) if (sb <= w) {
        const f32x4 u4 = *(const LAS f32x4*)(Ul + 16 * sb + 4 * G);
#pragma unroll
        for (int rg = 0; rg < 4; ++rg) { const int si = 16 * sb + 4 * G + rg; const float wgt = (si <= t) ? fexp(u4[rg] - at) : 0.f; const float v = s[sb][rg] * wgt; s[sb][rg] = v; dl += v; }
    }
    dl += __shfl_xor(dl, 16); dl += __shfl_xor(dl, 32);
    f32x4 nS[8], nC[8];
#pragma unroll
    for (int vb = 0; vb < 8; ++vb) { nS[vb] = (f32x4){0.f, 0.f, 0.f, 0.f}; nC[vb] = (f32x4){0.f, 0.f, 0.f, 0.f}; }
#pragma unroll
    for (int st = 0; st < 4; ++st) if (2 * st <= w) {
        const bf16x8 pb = pack8(s[2 * st], s[2 * st + 1]);
        const LAS unsigned char* vp = VT + (32 * st + 4 * G + q4) * 288 + 8 * p4;
#pragma unroll
        for (int vb = 0; vb < 8; ++vb) nS[vb] = MFMA16(cat4(tr_read(vp + 32 * vb), tr_read(vp + 32 * vb + 16 * 288)), pb, nS[vb]);
    }
    const bf16* Ct = F.CSNAP + ((size_t)(c * 4 + h) << 14);
#pragma unroll
    for (int vb = 0; vb < 8; ++vb)
#pragma unroll
        for (int ks = 0; ks < 4; ++ks) nC[vb] = MFMA16(*(const bf16x8*)(Ct + (16 * vb + col) * 128 + 32 * ks + 8 * G), qf[ks], nC[vb]);
    float qn = 0.f;
    { const float* np = F.NSNAP + (size_t)(c * 4 + h) * 128 + 8 * G;
#pragma unroll
      for (int ks = 0; ks < 4; ++ks) { const f32x4 n0 = *(const f32x4*)(np + 32 * ks), n1 = *(const f32x4*)(np + 32 * ks + 4); const v4u qw = __builtin_bit_cast(v4u, qf[ks]);
          qn += (bflo(qw.x) * n0.x + bfhi(qw.x) * n0.y) + (bflo(qw.y) * n0.z + bfhi(qw.y) * n0.w) + (bflo(qw.z) * n1.x + bfhi(qw.z) * n1.y) + (bflo(qw.w) * n1.z + bfhi(qw.w) * n1.w); } }
    qn += __shfl_xor(qn, 16); qn += __shfl_xor(qn, 32);
    const float iw = fexp(mc - at), den = dl + iw * qn, mt = btv + at, inv = 1.f / fmaxf(fabsf(den), fexp(-mt));
    float ss = 0.f;
#pragma unroll
    for (int vb = 0; vb < 8; ++vb)
#pragma unroll
        for (int rg = 0; rg < 4; ++rg) { const float hv = (nS[vb][rg] + iw * nC[vb][rg]) * inv; nS[vb][rg] = hv; ss += hv * hv; }
    ss += __shfl_xor(ss, 16); ss += __shfl_xor(ss, 32);
    const float rs = rsqrtf(ss * (1.f / 128.f) + RMS_EPS);
#pragma unroll
    for (int vb = 0; vb < 8; ++vb) {
        const int v0 = 16 * vb + 4 * G; const f32x4 gm = *(const f32x4*)(F.g_ml + 128 * h + v0);
        const v2u ow = *(const v2u*)(F.Z + row * NZ + ZOM + 128 * h + v0);
        const float o0 = bflo(ow.x), o1 = bfhi(ow.x), o2 = bflo(ow.y), o3 = bfhi(ow.y);
        v2u r; r.x = pk2(nS[vb][0] * rs * gm.x / (1.f + __expf(-o0)), nS[vb][1] * rs * gm.y / (1.f + __expf(-o1)));
        r.y = pk2(nS[vb][2] * rs * gm.z / (1.f + __expf(-o2)), nS[vb][3] * rs * gm.w / (1.f + __expf(-o3)));
        *(v2u*)(F.MIX + row * DM + 512 + 128 * h + v0) = r;
    }
    __syncthreads();
}
__device__ __forceinline__ void merge_item(Frame& F, int mi) {
#pragma unroll
    for (int i = 0; i < 4; ++i) {
        const int idx = F.tid + 512 * i, ch = idx & 7, hd = (idx >> 3) & 7, tk = idx >> 6; const size_t tok = (size_t)32 * mi + tk;
        const float L0 = F.LSE[tok * 8 + hd], L1 = F.LSE[((size_t)TP + tok) * 8 + hd], L2 = F.LSE[((size_t)2 * TP + tok) * 8 + hd];
        const float mx = fmaxf(L0, fmaxf(L1, L2)); float w0 = ex2(L0 - mx), w1 = ex2(L1 - mx), w2 = ex2(L2 - mx); const float iW = 1.f / (w0 + w1 + w2); w0 *= iW; w1 *= iW; w2 *= iW;
        const size_t po = tok * 512 + hd * 64 + ch * 8;
        const v4u a = *(const v4u*)(F.PART + po), b = *(const v4u*)(F.PART + (size_t)TP * 512 + po), cc = *(const v4u*)(F.PART + (size_t)2 * TP * 512 + po);
        v4u o;
        o.x = pk2(w0 * bflo(a.x) + w1 * bflo(b.x) + w2 * bflo(cc.x), w0 * bfhi(a.x) + w1 * bfhi(b.x) + w2 * bfhi(cc.x));
        o.y = pk2(w0 * bflo(a.y) + w1 * bflo(b.y) + w2 * bflo(cc.y), w0 * bfhi(a.y) + w1 * bfhi(b.y) + w2 * bfhi(cc.y));
        o.z = pk2(w0 * bflo(a.z) + w1 * bflo(b.z) + w2 * bflo(cc.z), w0 * bfhi(a.z) + w1 * bfhi(b.z) + w2 * bfhi(cc.z));
        o.w = pk2(w0 * bflo(a.w) + w1 * bflo(b.w) + w2 * bflo(cc.w), w0 * bfhi(a.w) + w1 * bfhi(b.w) + w2 * bfhi(cc.w));
        *(v4u*)(F.MIX + tok * DM + hd * 64 + ch * 8) = o;
    }
}

__device__ __forceinline__ void p6_ln1(Frame& F) {
    const int gw = F.vcu * NWAVES + F.wave, NGW = F.G * NWAVES, lane = F.lane;
    f32x4 g1[4], g2[4];
#pragma unroll
    for (int j = 0; j < 4; ++j) { g1[j] = *(const f32x4*)(F.g_post + 256 * j + 4 * lane); g2[j] = *(const f32x4*)(F.g_ffn + 256 * j + 4 * lane); }
    for (int m = gw; m < MALL; m += NGW) {
        const float* xrow = m < TP ? F.xp + (size_t)m * DM : F.xs + (size_t)(m - TP) * DM;
        const float* mr = F.MIXED + (size_t)m * DM;
        f32x4 v[4], x[4]; float s = 0.f;
#pragma unroll
        for (int j = 0; j < 4; ++j) { v[j] = *(const f32x4*)(mr + 256 * j + 4 * lane); x[j] = *(const f32x4*)(xrow + 256 * j + 4 * lane); s += (v[j].x * v[j].x + v[j].y * v[j].y) + (v[j].z * v[j].z + v[j].w * v[j].w); }
        const float rs = rsqrtf(wave_sum(s) * (1.f / DM) + RMS_EPS); float s2 = 0.f;
#pragma unroll
        for (int j = 0; j < 4; ++j) { x[j] = x[j] + v[j] * rs * g1[j]; s2 += (x[j].x * x[j].x + x[j].y * x[j].y) + (x[j].z * x[j].z + x[j].w * x[j].w); }
        const float rs2 = rsqrtf(wave_sum(s2) * (1.f / DM) + RMS_EPS);
        float* orow = F.out + (size_t)m * DM; bf16* nrow = F.XN + (size_t)m * DM;
#pragma unroll
        for (int j = 0; j < 4; ++j) { *(f32x4*)(orow + 256 * j + 4 * lane) = x[j];
            v2u o; o.x = pk2(x[j].x * rs2 * g2[j].x, x[j].y * rs2 * g2[j].y); o.y = pk2(x[j].z * rs2 * g2[j].z, x[j].w * rs2 * g2[j].w); *(v2u*)(nrow + 256 * j + 4 * lane) = o; }
    }
}
__device__ __forceinline__ void p10_ln2(Frame& F) {
    const int gw = F.vcu * NWAVES + F.wave, NGW = F.G * NWAVES, lane = F.lane;
    f32x4 g1[4];
#pragma unroll
    for (int j = 0; j < 4; ++j) g1[j] = *(const f32x4*)(F.g_fpost + 256 * j + 4 * lane);
    for (int m = gw; m < MALL; m += NGW) {
        const float* yr = F.Y + (size_t)m * DM; float* orow = F.out + (size_t)m * DM;
        f32x4 v[4], x[4]; float s = 0.f;
#pragma unroll
        for (int j = 0; j < 4; ++j) { v[j] = *(const f32x4*)(yr + 256 * j + 4 * lane); x[j] = *(const f32x4*)(orow + 256 * j + 4 * lane); s += (v[j].x * v[j].x + v[j].y * v[j].y) + (v[j].z * v[j].z + v[j].w * v[j].w); }
        const float rs = rsqrtf(wave_sum(s) * (1.f / DM) + RMS_EPS);
#pragma unroll
        for (int j = 0; j < 4; ++j) *(f32x4*)(orow + 256 * j + 4 * lane) = x[j] + v[j] * rs * g1[j];
    }
}
__device__ __forceinline__ float gelu_tanh(float x) { const float t = 0.7978845608028654f * (x + 0.044715f * x * x * x); const float e = __expf(2.f * t); return 0.5f * x * (1.f + (1.f - 2.f / (e + 1.f))); }
__device__ __forceinline__ void ld8(const bf16* p, float (&o)[8]) { const v4u w = *(const v4u*)p; o[0] = bflo(w.x); o[1] = bfhi(w.x); o[2] = bflo(w.y); o[3] = bfhi(w.y); o[4] = bflo(w.z); o[5] = bfhi(w.z); o[6] = bflo(w.w); o[7] = bfhi(w.w); }
__device__ __forceinline__ void ld8f(const float* p, float (&o)[8]) { const f32x4 a = *(const f32x4*)p, b = *(const f32x4*)(p + 4); o[0] = a.x; o[1] = a.y; o[2] = a.z; o[3] = a.w; o[4] = b.x; o[5] = b.y; o[6] = b.z; o[7] = b.w; }
__device__ __forceinline__ void st8f(float* p, const float (&o)[8]) { *(f32x4*)p = (f32x4){o[0], o[1], o[2], o[3]}; *(f32x4*)(p + 4) = (f32x4){o[4], o[5], o[6], o[7]}; }
__device__ __forceinline__ void p8_conv(Frame& F) {
    const size_t gt = (size_t)F.vcu * (NWAVES * 64) + F.tid, NT = (size_t)F.G * (NWAVES * 64);
    constexpr int NCC = DFF / 8, NRB = MALL / 16;
    for (size_t wi = gt; wi < (size_t)NCC * NRB; wi += NT) {
        const int cc = (int)(wi % NCC), rb = (int)(wi / NCC), c0 = 8 * cc, jt = c0 >> 7, ii = c0 & 127, gcol = 256 * jt + ii, vcol = gcol + 128;
        float wg[3][8], wv[3][8], bg[8], bv[8];
#pragma unroll
        for (int k = 0; k < 3; ++k) { ld8f(F.conv_w + (size_t)k * NUP + c0, wg[k]); ld8f(F.conv_w + (size_t)k * NUP + DFF + c0, wv[k]); }
        ld8f(F.conv_b + c0, bg); ld8f(F.conv_b + DFF + c0, bv);
        const int row0 = 16 * rb; const bool samp = row0 >= TP;
        float g2[8], g1[8], v2[8], v1[8];
        if (!samp) {
            if (row0 == 0) {
#pragma unroll
                for (int e = 0; e < 8; ++e) { g2[e] = 0.f; g1[e] = 0.f; v2[e] = 0.f; v1[e] = 0.f; }
            } else { ld8(F.U + (size_t)(row0 - 2) * NUP + gcol, g2); ld8(F.U + (size_t)(row0 - 1) * NUP + gcol, g1); ld8(F.U + (size_t)(row0 - 2) * NUP + vcol, v2); ld8(F.U + (size_t)(row0 - 1) * NUP + vcol, v1); }
        }
        for (int rr = 0; rr < 16; ++rr) {
            const int row = row0 + rr;
            if (samp && (rr & 7) == 0) { const int b = (row - TP) >> 3; const float* cs = F.st_conv + (size_t)b * 2 * NUP;
                ld8f(cs + c0, g2); ld8f(cs + NUP + c0, g1); ld8f(cs + DFF + c0, v2); ld8f(cs + NUP + DFF + c0, v1); }
            float g0[8], v0[8]; ld8(F.U + (size_t)row * NUP + gcol, g0); ld8(F.U + (size_t)row * NUP + vcol, v0);
            float a[8];
#pragma unroll
            for (int e = 0; e < 8; ++e) { const float ug = bg[e] + wg[0][e] * g2[e] + wg[1][e] * g1[e] + wg[2][e] * g0[e]; const float uv = bv[e] + wv[0][e] * v2[e] + wv[1][e] * v1[e] + wv[2][e] * v0[e]; a[e] = gelu_tanh(ug) * uv; }
            v4u o; o.x = pk2(a[0], a[1]); o.y = pk2(a[2], a[3]); o.z = pk2(a[4], a[5]); o.w = pk2(a[6], a[7]);
            *(v4u*)(F.ACT + (size_t)row * DFF + c0) = o;
            if (!samp) { if (row >= TP - 2) { float* d = F.out + O_CONVP + (size_t)(row - (TP - 2)) * NUP; st8f(d + c0, g0); st8f(d + DFF + c0, v0); } }
            else if ((rr & 7) >= 6) { const int b = (row - TP) >> 3; float* d = F.out + O_CONVS + ((size_t)b * 2 + ((rr & 7) - 6)) * NUP; st8f(d + c0, g0); st8f(d + DFF + c0, v0); }
#pragma unroll
            for (int e = 0; e < 8; ++e) { g2[e] = g1[e]; g1[e] = g0[e]; v2[e] = v1[e]; v1[e] = v0[e]; }
        }
    }
}

struct Args { const float* in[22]; float* out; unsigned char* ws; int ph_lo, ph_hi; };
__global__ void __launch_bounds__(NWAVES * 64, 2) hymba_fwd(Args args) {
    extern __shared__ __attribute__((aligned(16))) unsigned char lds[];
    Frame F;
    F.lds = (LAS unsigned char*)lds;
    F.MISC = (volatile LAS unsigned*)(F.lds + MISC_OFF);
    F.tid = threadIdx.x; F.lane = F.tid & 63; F.wave = __builtin_amdgcn_readfirstlane(F.tid >> 6);
    F.G = gridDim.x; { const int bx = blockIdx.x; F.vcu = (F.G % 8 == 0) ? (bx % 8) * (F.G / 8) + bx / 8 : bx; }
    unsigned char* ws = args.ws;
    F.ctl = (gu32*)(ws + WS_CTL);
    F.xp = args.in[0]; F.xs = args.in[1]; F.cache_k = args.in[2]; F.cache_v = args.in[3]; F.st_C = args.in[4]; F.st_n = args.in[5]; F.st_m = args.in[6]; F.st_conv = args.in[7];
    F.rel_bias = args.in[8]; F.g_pre = args.in[9]; F.w_in = args.in[10]; F.b_i = args.in[11]; F.b_f = args.in[12]; F.g_ml = args.in[13]; F.w_out = args.in[14]; F.g_post = args.in[15];
    F.g_ffn = args.in[16]; F.w_up = args.in[17]; F.conv_w = args.in[18]; F.conv_b = args.in[19]; F.w_down = args.in[20]; F.g_fpost = args.in[21];
    F.out = args.out;
    F.Win_t = (bf16*)(ws + WS_WIN); F.Wout_t = (bf16*)(ws + WS_WOUT); F.Wup_t = (bf16*)(ws + WS_WUP); F.Wdn_t = (bf16*)(ws + WS_WDN);
    F.XN = (bf16*)(ws + WS_XN); F.Z = (bf16*)(ws + WS_Z); F.PART = (bf16*)(ws + WS_PART); F.CSNAP = (bf16*)(ws + WS_CSNAP); F.MIX = (bf16*)(ws + WS_MIX); F.U = (bf16*)(ws + WS_U); F.ACT = (bf16*)(ws + WS_ACT);
    F.Gt = (float*)(ws + WS_G); F.GB = (float*)(ws + WS_GB); F.CS = (float*)(ws + WS_CS); F.BT = (float*)(ws + WS_BT); F.LSE = (float*)(ws + WS_LSE); F.DN = (float*)(ws + WS_DN); F.NSNAP = (float*)(ws + WS_NSNAP);
    F.DC = (float*)(ws + WS_DC); F.MIXED = (float*)(ws + WS_MIXED); F.Y = (float*)(ws + WS_Y);
    for (int u = F.tid; u < (LDS_BYTES - LDSCTL_OFF) / 4; u += NWAVES * 64) ((LAS unsigned*)(F.lds + LDSCTL_OFF))[u] = 0u;
    __syncthreads();
    XcdBarrier bar = xcd_barrier_post((unsigned*)(F.ctl + CW_BAR), F.MISC + 8);
    const int lo = args.ph_lo, hi = args.ph_hi;
#ifdef ONLY
#define IN(k) ((k) == ONLY && lo <= (k) && (k) < hi)
#else
#define IN(k) (lo <= (k) && (k) < hi)
#endif
#define SEAM(k) do { if (IN(k) && IN((k) + 1)) xcd_barrier(bar); } while (0)
    LAS float* ms = (LAS float*)(F.lds + MS_OFF);

    if (IN(0)) { p0_prologue(F); } SEAM(0);
    if (IN(1)) {
        chunk_stats(F);
        pg8::Gemm g{F.XN, F.Win_t, MALL, NZ, DM}; pg8::StaticOrder S; S.init(MALL, NZ, F.G, (int)blockIdx.x);
        pg8::EpiZ E{F.Z, F.out};
        pg8::gemm_phase<pg8::EpiZ, pg8::StaticOrder, true, true>(F.lds + RING_OFF, g, S, E);
    } SEAM(1);
    if (IN(2)) {
        mscan_to_lds(F, ms);
        constexpr int NATT = 3072, NDC = 512, NSA = 256, NSM = 128;
        for (int it = F.vcu; it < NATT + NDC + NSA + NSM; it += F.G) {
#ifndef UNIT
#define UNIT 15
#endif
            if (it < NATT) { if (UNIT & 1) attn_unit(F, it); }
            else if (it < NATT + NDC) { if (UNIT & 2) dc_unit(F, it - NATT, ms); }
            else if (it < NATT + NDC + NSA) { if (UNIT & 4) sattn_unit(F, it - NATT - NDC); }
            else { if (UNIT & 8) smlstm_unit(F, it - NATT - NDC - NSA); }
        }
    } SEAM(2);
    if (IN(3)) { p3_scan(F); } SEAM(3);
    if (IN(4)) {
        mscan_to_lds(F, ms);
        for (int it = F.vcu; it < 512 + 512; it += F.G) { if (it < 512) mout_unit(F, it, ms); else merge_item(F, it - 512); }
    } SEAM(4);
    if (IN(5)) {
        pg8::Gemm g{F.MIX, F.Wout_t, MALL, DM, DM}; pg8::StaticOrder S; S.init(MALL, DM, F.G, (int)blockIdx.x);
        pg8::EpiF32 E{F.MIXED, DM};
        pg8::gemm_phase<pg8::EpiF32, pg8::StaticOrder, true, true>(F.lds + RING_OFF, g, S, E);
    } SEAM(5);
    if (IN(6)) { p6_ln1(F); } SEAM(6);
    if (IN(7)) {
        pg8::Gemm g{F.XN, F.Wup_t, MALL, NUP, DM}; pg8::StaticOrder S; S.init(MALL, NUP, F.G, (int)blockIdx.x);
        pg8::EpiBf16<0> E{F.U, NUP, nullptr, 0, 0, 1.f};
        pg8::gemm_phase<pg8::EpiBf16<0>, pg8::StaticOrder, true, true>(F.lds + RING_OFF, g, S, E);
    } SEAM(7);
    if (IN(8)) { p8_conv(F); } SEAM(8);
    if (IN(9)) {
        pg8::Gemm g{F.ACT, F.Wdn_t, MALL, DM, DFF}; pg8::StaticOrder S; S.init(MALL, DM, F.G, (int)blockIdx.x);
        pg8::EpiF32 E{F.Y, DM};
        pg8::gemm_phase<pg8::EpiF32, pg8::StaticOrder, true, true>(F.lds + RING_OFF, g, S, E);
    } SEAM(9);
    if (IN(10)) { p10_ln2(F); }
#undef IN
#undef SEAM
}

#ifndef N_LAUNCHES
#define N_LAUNCHES 1
#endif
extern "C" void kernel_launch(void* const* d_in, const int* in_sizes, int n_in, void* d_out, int out_size, void* d_ws, size_t ws_size, hipStream_t stream) {
    static int grid = 0;
    if (grid == 0) {
        if (n_in != 22 || in_sizes[0] != TP * DM || (size_t)out_size != O_END || ws_size < WS_END) {
            fprintf(stderr, "kernel_launch: unexpected shapes: n_in %d in0 %d out %d ws %zu (need %zu)\n", n_in, n_in > 0 ? in_sizes[0] : -1, out_size, ws_size, (size_t)WS_END); grid = -1; return; }
        int dev = 0, cus = 0, per_cu = 0;
        if (hipGetDevice(&dev) != hipSuccess || hipDeviceGetAttribute(&cus, hipDeviceAttributeMultiprocessorCount, dev) != hipSuccess) { grid = -1; return; }
        if (hipFuncSetAttribute((const void*)hymba_fwd, hipFuncAttributeMaxDynamicSharedMemorySize, LDS_BYTES) != hipSuccess) { fprintf(stderr, "kernel_launch: hipFuncSetAttribute failed\n"); grid = -1; return; }
        if (hipOccupancyMaxActiveBlocksPerMultiprocessor(&per_cu, (const void*)hymba_fwd, NWAVES * 64, LDS_BYTES) != hipSuccess || per_cu < 1) {
            fprintf(stderr, "kernel_launch: occupancy query reports %d workgroups per CU; nothing launched\n", per_cu); (void)hipGetLastError(); grid = -1; return; }
        grid = cus;
    }
    if (grid < 0) return;
    if (hipMemsetAsync((char*)d_ws + WS_CTL, 0, CTL_ZERO_BYTES, stream) != hipSuccess) { fprintf(stderr, "kernel_launch: memset failed\n"); return; }
    Args a{};
    for (int i = 0; i < 22; ++i) a.in[i] = (const float*)d_in[i];
    a.out = (float*)d_out; a.ws = (unsigned char*)d_ws;
#if N_LAUNCHES == 1
    a.ph_lo = 0; a.ph_hi = 11;
    hipLaunchKernelGGL(hymba_fwd, dim3(grid), dim3(NWAVES * 64), LDS_BYTES, stream, a);
#else
    for (int p = 0; p < 11; ++p) { a.ph_lo = p; a.ph_hi = p + 1; hipLaunchKernelGGL(hymba_fwd, dim3(grid), dim3(NWAVES * 64), LDS_BYTES, stream, a); }
#endif
    const hipError_t le = hipPeekAtLastError();
    if (le != hipSuccess) fprintf(stderr, "kernel_launch: launch failed: %s (grid %d)\n", hipGetErrorName(le), grid);
}
```

```cpp
#include <hip/hip_runtime.h>
#include <cstdio>
#include <cstdint>
namespace pg8 {
#define PG8_LAS __attribute__((address_space(3)))
typedef unsigned short bf16_t;
typedef short bf16x8 __attribute__((ext_vector_type(8)));
typedef float f32x4 __attribute__((ext_vector_type(4)));
typedef unsigned u32x4 __attribute__((ext_vector_type(4)));
constexpr int BM = 256, BK = 64, HALF = 128, HTB = HALF * BK * 2  , STAGE_BYTES = 8 * HTB, NXCD = 8, WGM = 8;

__host__ __device__ __forceinline__ int lds_byte(int r, int c) { const int st = (r >> 4) * 2 + (c >> 5), rr = r & 15, cc = c & 31, ob = rr * 64 + cc * 2; return st * 1024 + (ob ^ (((ob >> 9) & 1) << 5)); }
__host__ __device__ __forceinline__ void stage_rc(int b, int& R, int& C) { const int st = b / 1024, sb = b % 1024, swz = sb ^ (((sb >> 9) & 1) << 5); R = (st >> 1) * 16 + swz / 64; C = (st & 1) * 32 + (swz % 64) / 2; }
__host__ __device__ __forceinline__ int perm32(int rho) { const int n = rho >> 4, i = rho & 15; return 8 * (i >> 2) + 4 * n + (i & 3); }

struct Unit { int pm, pn; };
struct Gemm { const bf16_t* A; const bf16_t* Bt; int M, N, K; };

struct StaticOrder {
    int nM, nN, nwg, G, c;
    __host__ __device__ void init(int M, int N, int G_, int c_) { nM = M / BM; nN = N / BM; nwg = nM * nN; G = G_; c = c_; }
    __host__ __device__ bool next(int i, Unit& u) const {
        const long L = (long)i * G + c; if (L >= nwg) return false;
        int wgid = (int)L; { const int q = nwg / NXCD, r = nwg % NXCD, xcd = wgid % NXCD, off = wgid / NXCD; wgid = (xcd < r ? xcd * (q + 1) : r * (q + 1) + (xcd - r) * q) + off; }
        const int nig = WGM * nN, gid = wgid / nig, fm = gid * WGM, gsz = (nM - fm) < WGM ? (nM - fm) : WGM;
        u.pm = fm + ((wgid % nig) % gsz); u.pn = (wgid % nig) / gsz; return true;
    }
    __device__ __forceinline__ void a_ready(const Unit&) const {}
    __device__ __forceinline__ void done(const Unit&) const {}
};

__device__ __forceinline__ unsigned cvt_pk_bf16(float lo, float hi) { unsigned r; asm volatile("v_cvt_pk_bf16_f32 %0, %1, %2" : "=v"(r) : "v"(lo), "v"(hi)); return r; }
typedef float f32x2 __attribute__((ext_vector_type(2)));
__device__ __forceinline__ f32x2 gelu_pk(f32x2 v) {
    const f32x2 av = __builtin_elementwise_abs(v), d = av * 0.2316418882f + 1.0f;
    f32x2 t; t.x = __builtin_amdgcn_rcpf(d.x); t.y = __builtin_amdgcn_rcpf(d.y);
    f32x2 q = t * 0.5307027145f + (-0.7265760135f); q = q * t + 0.7107068705f; q = q * t + (-0.142248368f); q = q * t + 0.127414796f; q = q * t;
    const f32x2 s = (v * v) * (-0.72134752044f);
    f32x2 e; e.x = __builtin_amdgcn_exp2f(s.x); e.y = __builtin_amdgcn_exp2f(s.y);
    const f32x2 m = v * (q * e), r = v - m;
    f32x2 o; o.x = v.x < 0.f ? m.x : r.x; o.y = v.y < 0.f ? m.y : r.y; return o;
}

template <int ACT  > struct EpiBf16 {
    static constexpr bool PERM = true, AFTER_DRAIN = false; static_assert(ACT == 0 || ACT == 1, "EpiBf16: ACT is 0 (none) or 1 (gelu_pk)");
    bf16_t* O; int ldc; const float* bias; int split_cols; size_t split_stride; float scale0;
    __device__ __forceinline__ void operator()(const f32x4 (&acc)[2][2][4][2], const Unit& u, int wr, int wc, int fr, int fq) const {
        const int row0 = u.pm * BM + wr * 64 + fr; int colt = u.pn * BM; bf16_t* base = O;
        float sc = 1.f; if (split_cols) { const int t = colt / split_cols; base += (size_t)t * split_stride; colt -= t * split_cols; if (t == 0) sc = scale0; }
        const int col0 = colt + wc * 32 + 8 * fq, bcol0 = u.pn * BM + wc * 32 + 8 * fq;
        f32x4 bv[2][2];
#pragma unroll
        for (int bj = 0; bj < 2; ++bj)
#pragma unroll
            for (int n = 0; n < 2; ++n) bv[bj][n] = bias ? *(const f32x4*)(bias + bcol0 + bj * HALF + 4 * n) : (f32x4){0.f, 0.f, 0.f, 0.f};
#pragma unroll
        for (int ai = 0; ai < 2; ++ai)
#pragma unroll
            for (int m = 0; m < 4; ++m) { bf16_t* rowp = base + (size_t)(row0 + ai * HALF + m * 16) * ldc + col0;
#pragma unroll
                for (int bj = 0; bj < 2; ++bj) { f32x4 v0 = acc[ai][bj][m][0] + bv[bj][0], v1 = acc[ai][bj][m][1] + bv[bj][1];
                    if (ACT == 1) { f32x2 a = gelu_pk((f32x2){v0[0], v0[1]}), b = gelu_pk((f32x2){v0[2], v0[3]}), c = gelu_pk((f32x2){v1[0], v1[1]}), d = gelu_pk((f32x2){v1[2], v1[3]});
                        v0 = (f32x4){a.x, a.y, b.x, b.y}; v1 = (f32x4){c.x, c.y, d.x, d.y}; }
                    v0 = v0 * sc; v1 = v1 * sc; u32x4 w; w.x = cvt_pk_bf16(v0[0], v0[1]); w.y = cvt_pk_bf16(v0[2], v0[3]); w.z = cvt_pk_bf16(v1[0], v1[1]); w.w = cvt_pk_bf16(v1[2], v1[3]);
                    *(u32x4*)(rowp + bj * HALF) = w; } }
    }
};

struct PanelStats {
    unsigned* xbuf;
    unsigned* cnt;
    unsigned* tmo;
    int ntn; float eps;
    unsigned code;
    __device__ __forceinline__ bool run(const f32x4 (&v)[2][2][4][2], const Unit& u, int wr, int wc, int fr, int fq, PG8_LAS unsigned char* lds, int wid, int lane) const {
        typedef float f32x2v __attribute__((ext_vector_type(2)));
        PG8_LAS f32x2v* P = (PG8_LAS f32x2v*)lds;
        PG8_LAS f32x2v* S = (PG8_LAS f32x2v*)(lds + 8192);
        PG8_LAS unsigned* flag = (PG8_LAS unsigned*)(lds + 8192 + 2048);
#pragma unroll
        for (int ai = 0; ai < 2; ++ai)
#pragma unroll
            for (int m = 0; m < 4; ++m) {
                float s = 0.f;
#pragma unroll
                for (int bj = 0; bj < 2; ++bj)
#pragma unroll
                    for (int n = 0; n < 2; ++n) { const f32x4 x = v[ai][bj][m][n]; s += (x[0] + x[1]) + (x[2] + x[3]); }
                s += __shfl_xor(s, 16); s += __shfl_xor(s, 32);
                const float mw = s * (1.0f / 64.0f); float q = 0.f;
#pragma unroll
                for (int bj = 0; bj < 2; ++bj)
#pragma unroll
                    for (int n = 0; n < 2; ++n) { const f32x4 d = v[ai][bj][m][n] - mw; q += (d[0] * d[0] + d[1] * d[1]) + (d[2] * d[2] + d[3] * d[3]); }
                q += __shfl_xor(q, 16); q += __shfl_xor(q, 32);
                if (fq == 0) P[(ai * HALF + wr * 64 + m * 16 + fr) * 4 + wc] = (f32x2v){mw, q};
            }
        asm volatile("s_waitcnt lgkmcnt(0)" ::: "memory"); __builtin_amdgcn_s_barrier(); asm volatile("" ::: "memory");
#if defined(BROKEN_EXCHANGE_NO_WAIT)
#warning BROKEN CONTROL BUILD: the row-statistics exchange does not wait; results are wrong by design
        if (blockIdx.x >= 64) { const long long t0_ = clock64(); while (clock64() - t0_ < 60000) __builtin_amdgcn_s_sleep(8); }
#endif
        const int row = wid * 32 + (lane & 31);
        if (lane < 32) {
            const f32x2v a = P[row * 4 + 0], b = P[row * 4 + 1], c = P[row * 4 + 2], d = P[row * 4 + 3];
            const float mt = (a.x + b.x + c.x + d.x) * 0.25f;
            const float da = a.x - mt, db = b.x - mt, dc = c.x - mt, dd = d.x - mt;
            const float m2 = (a.y + b.y) + (c.y + d.y) + 64.0f * ((da * da + db * db) + (dc * dc + dd * dd));
            unsigned long long* slot = (unsigned long long*)xbuf + ((size_t)(u.pm * BM + row) * 4 + u.pn);
            __hip_atomic_store(slot, ((unsigned long long)__float_as_uint(m2) << 32) | __float_as_uint(mt), __ATOMIC_RELAXED, __HIP_MEMORY_SCOPE_AGENT);
        }
        asm volatile("s_waitcnt vmcnt(0)" ::: "memory");
        if (lane == 0) __hip_atomic_fetch_add(cnt + 64 * u.pm, 1u, __ATOMIC_RELAXED, __HIP_MEMORY_SCOPE_AGENT);
        if (wid == 0) {
            bool dead = false; const unsigned long long t0 = __builtin_amdgcn_s_memrealtime(); const unsigned want = 8u * (unsigned)ntn;
            for (;;) {
#if defined(BROKEN_EXCHANGE_NO_WAIT)
                break;
#endif
                if ((unsigned)__builtin_amdgcn_readfirstlane(__hip_atomic_load(cnt + 64 * u.pm, __ATOMIC_RELAXED, __HIP_MEMORY_SCOPE_AGENT)) >= want) break;
                if (__builtin_amdgcn_s_memrealtime() - t0 > 2000000ull) {
                    if (lane == 0) { unsigned expect = 0u; __hip_atomic_compare_exchange_strong(tmo + 1, &expect, code | (unsigned)(u.pm & 0xff), __ATOMIC_RELAXED, __ATOMIC_RELAXED, __HIP_MEMORY_SCOPE_AGENT);
                                     __hip_atomic_store(tmo, 1u, __ATOMIC_RELAXED, __HIP_MEMORY_SCOPE_AGENT); }
                    dead = true; break; }
                __builtin_amdgcn_s_sleep(2);
            }
            __builtin_amdgcn_fence(__ATOMIC_ACQUIRE, "agent");
            if (lane == 0) flag[0] = dead ? 1u : 0u;
        }
        asm volatile("s_waitcnt vmcnt(0) lgkmcnt(0)" ::: "memory"); __builtin_amdgcn_s_barrier(); asm volatile("" ::: "memory");
        const bool bad = flag[0] != 0u;
        if (lane < 32) {
            const unsigned long long* slot = (const unsigned long long*)xbuf + (size_t)(u.pm * BM + row) * 4; float mt[4], m2[4]; float ms = 0.f;
#pragma unroll
            for (int t = 0; t < 4; ++t) { if (t < ntn) { const unsigned long long w = __hip_atomic_load(slot + t, __ATOMIC_RELAXED, __HIP_MEMORY_SCOPE_AGENT); mt[t] = __uint_as_float((unsigned)w); m2[t] = __uint_as_float((unsigned)(w >> 32)); } else { mt[t] = 0.f; m2[t] = 0.f; } ms += mt[t]; }
            const float mean = ms / (float)ntn; float q = 0.f;
#pragma unroll
            for (int t = 0; t < 4; ++t) if (t < ntn) { const float dm = mt[t] - mean; q += m2[t] + 256.0f * dm * dm; }
            S[row] = (f32x2v){mean, 1.0f / sqrtf(q / (256.0f * (float)ntn) + eps)};
        }
        asm volatile("s_waitcnt lgkmcnt(0)" ::: "memory"); __builtin_amdgcn_s_barrier(); asm volatile("" ::: "memory");
        return bad;
    }
};
struct EpiLnRes {
    static constexpr bool PERM = false, AFTER_DRAIN = true;
    const float* base; float* out; int ldc; const float* bias; PanelStats st; unsigned poison;
    __device__ __forceinline__ void fused(f32x4 (&acc)[2][2][4][2], const Unit& u, int wr, int wc, int fr, int fq, PG8_LAS unsigned char* lds, int wid, int lane) const {
        typedef float f32x2v __attribute__((ext_vector_type(2)));
        const PG8_LAS f32x2v* S = (const PG8_LAS f32x2v*)(lds + 8192);
        const int col0 = u.pn * BM + wc * 32 + 4 * fq;
#pragma unroll
        for (int bj = 0; bj < 2; ++bj)
#pragma unroll
            for (int n = 0; n < 2; ++n) { const f32x4 bv = bias ? *(const f32x4*)(bias + col0 + bj * HALF + n * 16) : (f32x4){0.f, 0.f, 0.f, 0.f};
#pragma unroll
                for (int ai = 0; ai < 2; ++ai)
#pragma unroll
                    for (int m = 0; m < 4; ++m) acc[ai][bj][m][n] += bv; }
        f32x4 pre[4][2][2];
#pragma unroll
        for (int m = 0; m < 4; ++m) { const size_t off = (size_t)(u.pm * BM + wr * 64 + m * 16 + fr) * ldc + col0;
#pragma unroll
            for (int bj = 0; bj < 2; ++bj)
#pragma unroll
                for (int n = 0; n < 2; ++n) pre[m][bj][n] = *(const f32x4*)(base + off + bj * HALF + n * 16); }
        const bool bad = st.run(acc, u, wr, wc, fr, fq, lds, wid, lane) || poison != 0u;
        const float qnan = __builtin_nanf("");
#pragma unroll
        for (int ai = 0; ai < 2; ++ai)
#pragma unroll
            for (int m = 0; m < 4; ++m) { const int r = ai * HALF + wr * 64 + m * 16 + fr; const f32x2v sr = S[r]; const size_t off = (size_t)(u.pm * BM + r) * ldc + col0;
#pragma unroll
                for (int bj = 0; bj < 2; ++bj)
#pragma unroll
                    for (int n = 0; n < 2; ++n) { const f32x4 bs = ai == 0 ? pre[m][bj][n] : *(const f32x4*)(base + off + bj * HALF + n * 16); f32x4 o = bs + (acc[ai][bj][m][n] - sr.x) * sr.y;
                        if (bad) o = (f32x4){qnan, qnan, qnan, qnan}; *(f32x4*)(out + off + bj * HALF + n * 16) = o; }
                if (m & 1) asm volatile("" ::: "memory"); }
    }
};
struct EpiLnResLn {
    static constexpr bool PERM = false, AFTER_DRAIN = true;
    const float* base; float* out; bf16_t* xn; int ldc; const float* bias; PanelStats st1, st2; unsigned poison;
    __device__ __forceinline__ void fused(f32x4 (&acc)[2][2][4][2], const Unit& u, int wr, int wc, int fr, int fq, PG8_LAS unsigned char* lds, int wid, int lane) const {
        typedef float f32x2v __attribute__((ext_vector_type(2))); typedef unsigned u32x2v __attribute__((ext_vector_type(2)));
        const PG8_LAS f32x2v* S = (const PG8_LAS f32x2v*)(lds + 8192);
        const int col0 = u.pn * BM + wc * 32 + 4 * fq;
#pragma unroll
        for (int bj = 0; bj < 2; ++bj)
#pragma unroll
            for (int n = 0; n < 2; ++n) { const f32x4 bv = bias ? *(const f32x4*)(bias + col0 + bj * HALF + n * 16) : (f32x4){0.f, 0.f, 0.f, 0.f};
#pragma unroll
                for (int ai = 0; ai < 2; ++ai)
#pragma unroll
                    for (int m = 0; m < 4; ++m) acc[ai][bj][m][n] += bv; }
        bool bad = st1.run(acc, u, wr, wc, fr, fq, lds, wid, lane) || poison != 0u;
        const float qnan = __builtin_nanf("");
#pragma unroll
        for (int ai = 0; ai < 2; ++ai)
#pragma unroll
            for (int m = 0; m < 4; ++m) { const int r = ai * HALF + wr * 64 + m * 16 + fr; const f32x2v sr = S[r]; const size_t off = (size_t)(u.pm * BM + r) * ldc + col0;
#pragma unroll
                for (int bj = 0; bj < 2; ++bj)
#pragma unroll
                    for (int n = 0; n < 2; ++n) { const f32x4 bs = *(const f32x4*)(base + off + bj * HALF + n * 16); acc[ai][bj][m][n] = bs + (acc[ai][bj][m][n] - sr.x) * sr.y; }
                asm volatile("" : "+v"(acc[ai][0][m][0]), "+v"(acc[ai][0][m][1]), "+v"(acc[ai][1][m][0]), "+v"(acc[ai][1][m][1]));
                if (m & 1) asm volatile("" ::: "memory"); }
        const bool bad1 = bad;
        bad = st2.run(acc, u, wr, wc, fr, fq, lds, wid, lane) || bad;
#pragma unroll
        for (int ai = 0; ai < 2; ++ai)
#pragma unroll
            for (int m = 0; m < 4; ++m) { const int r = ai * HALF + wr * 64 + m * 16 + fr; const f32x2v sr = S[r]; const size_t off = (size_t)(u.pm * BM + r) * ldc + col0;
#pragma unroll
                for (int bj = 0; bj < 2; ++bj)
#pragma unroll
                    for (int n = 0; n < 2; ++n) { const f32x4 x1 = acc[ai][bj][m][n]; *(f32x4*)(out + off + bj * HALF + n * 16) = bad1 ? (f32x4){qnan, qnan, qnan, qnan} : x1;
                        const f32x4 o = (x1 - sr.x) * sr.y; u32x2v w; w.x = cvt_pk_bf16(o[0], o[1]); w.y = cvt_pk_bf16(o[2], o[3]);
                        if (bad) { w.x = 0x7fc07fc0u; w.y = 0x7fc07fc0u; } *(u32x2v*)(xn + off + bj * HALF + n * 16) = w; }
                asm volatile("" ::: "memory"); }
    }
};

template <class Epi, class Sched, bool ALIGN_EPI = false, bool SP2 = false>
__device__ __forceinline__ void gemm_phase(PG8_LAS unsigned char* lds, const Gemm g, const Sched& S, const Epi& E) {
    const int tid = threadIdx.x, wid = __builtin_amdgcn_readfirstlane(tid >> 6), lane = tid & 63, wr = wid >> 2, wc = wid & 3, fr = lane & 15, fq = lane >> 4;
    const int K = g.K, nt = K / BK;
    unsigned voffA[2], voffB[2];
#pragma unroll
    for (int i = 0; i < 2; ++i) { int R, C; stage_rc(tid * 16 + i * 8192, R, C); const int Rb = Epi::PERM ? ((R & ~31) + perm32(R & 31)) : R;
        voffA[i] = (unsigned)(R * K + C) * 2u; voffB[i] = (unsigned)(Rb * K + C) * 2u; }
    const size_t kstep = (size_t)(BK * 2);
    const size_t hstep = (size_t)HALF * K * 2;
    const size_t tstep = 2 * hstep;
    const unsigned ldsw = (unsigned)wid * 1024u;
    const int aoff = lds_byte(wr * 64 + fr, fq * 8), boff = lds_byte(wc * 32 + fr, fq * 8);
#define PG8_SA(b, h) (((b) * 2 + (h)) * HTB)
#define PG8_SB(b, h) ((4 + (b) * 2 + (h)) * HTB)
#define PG8_STAGE(bufoff, gbase, voff) do { _Pragma("unroll") for (int _i = 0; _i < 2; ++_i) \
        __builtin_amdgcn_global_load_lds((const unsigned*)((const char*)(gbase) + (voff)[_i]), (PG8_LAS unsigned*)(lds + (bufoff) + ldsw + _i * 8192), 16, 0, 0); } while (0)
#define PG8_LDA(dst, b, h) do { _Pragma("unroll") for (int m = 0; m < 4; ++m) _Pragma("unroll") for (int k = 0; k < 2; ++k) dst[m][k] = *(const PG8_LAS bf16x8*)(lds + PG8_SA(b, h) + aoff + m * 2048 + k * 1024); } while (0)
#define PG8_LDB(dst, b, h) do { _Pragma("unroll") for (int n = 0; n < 2; ++n) _Pragma("unroll") for (int k = 0; k < 2; ++k) dst[n][k] = *(const PG8_LAS bf16x8*)(lds + PG8_SB(b, h) + boff + n * 2048 + k * 1024); } while (0)
#define PG8_MMA(ai, bj, At, Bt) do { __builtin_amdgcn_s_setprio(1); _Pragma("unroll") for (int m = 0; m < 4; ++m) _Pragma("unroll") for (int n = 0; n < 2; ++n) _Pragma("unroll") for (int k = 0; k < 2; ++k) \
        acc[ai][bj][m][n] = __builtin_amdgcn_mfma_f32_16x16x32_bf16(Bt[n][k], At[m][k], acc[ai][bj][m][n], 0, 0, 0); __builtin_amdgcn_s_setprio(0); } while (0)
#define PG8_WAIT_V(n) asm volatile("s_waitcnt vmcnt(" #n ")" ::: "memory")
#define PG8_WAIT_L(n) asm volatile("s_waitcnt lgkmcnt(" #n ")" ::: "memory")
#define PG8_BAR __builtin_amdgcn_s_barrier()
#define PG8_SCHED __builtin_amdgcn_sched_barrier(0)
    Unit cur, nxt; int ui = 0;
    if (!S.next(0, cur)) return;
    f32x4 acc[2][2][4][2];
#pragma unroll
    for (int a = 0; a < 2; ++a)
#pragma unroll
        for (int b = 0; b < 2; ++b)
#pragma unroll
            for (int m = 0; m < 4; ++m)
#pragma unroll
                for (int n = 0; n < 2; ++n) acc[a][b][m][n] = (f32x4){0.f, 0.f, 0.f, 0.f};
    bf16x8 At[4][2], B0[2][2], B1[2][2];
    const char* cA = (const char*)g.A + (size_t)cur.pm * tstep; const char* cB = (const char*)g.Bt + (size_t)cur.pn * tstep;
    S.a_ready(cur);
    if constexpr (SP2) {
        PG8_STAGE(PG8_SB(0, 0), cB, voffB); PG8_STAGE(PG8_SB(0, 1), cB + hstep, voffB); PG8_STAGE(PG8_SA(0, 0), cA, voffA); PG8_STAGE(PG8_SA(0, 1), cA + hstep, voffA);
        if (wr == 1) PG8_BAR;
        PG8_WAIT_V(2); PG8_BAR;
        PG8_STAGE(PG8_SB(1, 0), cB + kstep, voffB); PG8_STAGE(PG8_SA(1, 0), cA + kstep, voffA); PG8_STAGE(PG8_SB(1, 1), cB + hstep + kstep, voffB);
        PG8_WAIT_V(6); PG8_BAR;
    } else {
        PG8_STAGE(PG8_SB(0, 0), cB, voffB); PG8_STAGE(PG8_SA(0, 0), cA, voffA); PG8_STAGE(PG8_SB(0, 1), cB + hstep, voffB); PG8_STAGE(PG8_SA(0, 1), cA + hstep, voffA);
        if (wr == 1) PG8_BAR;
        PG8_WAIT_V(4); PG8_BAR;
        PG8_STAGE(PG8_SB(1, 0), cB + kstep, voffB); PG8_STAGE(PG8_SA(1, 0), cA + kstep, voffA); PG8_STAGE(PG8_SB(1, 1), cB + hstep + kstep, voffB);
        PG8_WAIT_V(6); PG8_BAR;
    }
    for (;;) {
        const bool has_next = S.next(ui + 1, nxt);
        const char* nA = has_next ? (const char*)g.A + (size_t)nxt.pm * tstep : cA; const char* nB = has_next ? (const char*)g.Bt + (size_t)nxt.pn * tstep : cB;
        for (int t = 0; t < nt; t += 2) {
            const bool last = (t == nt - 2);
            const char* a1 = cA + (size_t)(t + 1) * kstep;
            const char* a2 = last ? nA : cA + (size_t)(t + 2) * kstep; const char* b2 = last ? nB : cB + (size_t)(t + 2) * kstep;
            const char* a3 = a2 + kstep; const char* b3 = b2 + kstep;
            if (last && has_next) S.a_ready(nxt);
            if constexpr (SP2) {
            PG8_LDB(B0, 0, 0); PG8_LDB(B1, 0, 1); PG8_SCHED; PG8_LDA(At, 0, 0); PG8_STAGE(PG8_SA(1, 1), a1 + hstep, voffA);
            PG8_WAIT_V(8); PG8_WAIT_L(0); PG8_BAR; PG8_MMA(0, 0, At, B0); PG8_MMA(0, 1, At, B1); PG8_BAR; PG8_SCHED;
            PG8_LDA(At, 0, 1); PG8_STAGE(PG8_SB(0, 0), b2, voffB); PG8_STAGE(PG8_SB(0, 1), b2 + hstep, voffB); PG8_STAGE(PG8_SA(0, 0), a2, voffA);
            PG8_WAIT_V(8); PG8_WAIT_L(0); PG8_BAR; PG8_MMA(1, 0, At, B0); PG8_MMA(1, 1, At, B1); PG8_BAR; PG8_SCHED;
            PG8_LDB(B0, 1, 0); PG8_LDB(B1, 1, 1); PG8_SCHED; PG8_LDA(At, 1, 0); PG8_STAGE(PG8_SA(0, 1), a2 + hstep, voffA);
            PG8_WAIT_V(8); PG8_WAIT_L(0); PG8_BAR; PG8_MMA(0, 0, At, B0); PG8_MMA(0, 1, At, B1); PG8_BAR; PG8_SCHED;
            PG8_LDA(At, 1, 1); PG8_STAGE(PG8_SB(1, 0), b3, voffB); PG8_STAGE(PG8_SB(1, 1), b3 + hstep, voffB); PG8_STAGE(PG8_SA(1, 0), a3, voffA);
            PG8_WAIT_V(8); PG8_WAIT_L(0); PG8_BAR; PG8_MMA(1, 0, At, B0); PG8_MMA(1, 1, At, B1); PG8_BAR; PG8_SCHED;
            } else {
            PG8_LDB(B0, 0, 0); PG8_SCHED; PG8_LDA(At, 0, 0); PG8_STAGE(PG8_SA(1, 1), a1 + hstep, voffA);
            PG8_WAIT_L(8); PG8_BAR; PG8_WAIT_L(0); PG8_MMA(0, 0, At, B0); PG8_BAR; PG8_SCHED;
            PG8_LDB(B1, 0, 1); PG8_STAGE(PG8_SB(0, 0), b2, voffB);
            PG8_BAR; PG8_WAIT_L(0); PG8_MMA(0, 1, At, B1); PG8_BAR;
            PG8_LDA(At, 0, 1); PG8_STAGE(PG8_SA(0, 0), a2, voffA);
            PG8_BAR; PG8_WAIT_L(0); PG8_MMA(1, 0, At, B0); PG8_BAR; PG8_SCHED;
            PG8_STAGE(PG8_SB(0, 1), b2 + hstep, voffB);
            PG8_WAIT_V(6); PG8_BAR; PG8_MMA(1, 1, At, B1); PG8_BAR;
            PG8_LDB(B0, 1, 0); PG8_SCHED; PG8_LDA(At, 1, 0); PG8_STAGE(PG8_SA(0, 1), a2 + hstep, voffA);
            PG8_WAIT_L(8); PG8_BAR; PG8_WAIT_L(0); PG8_MMA(0, 0, At, B0); PG8_BAR; PG8_SCHED;
            PG8_LDB(B1, 1, 1); PG8_STAGE(PG8_SB(1, 0), b3, voffB);
            PG8_BAR; PG8_WAIT_L(0); PG8_MMA(0, 1, At, B1); PG8_BAR;
            PG8_LDA(At, 1, 1); PG8_STAGE(PG8_SA(1, 0), a3, voffA);
            PG8_BAR; PG8_WAIT_L(0); PG8_MMA(1, 0, At, B0); PG8_BAR; PG8_SCHED;
            PG8_STAGE(PG8_SB(1, 1), b3 + hstep, voffB);
            PG8_WAIT_V(6); PG8_BAR; PG8_MMA(1, 1, At, B1); PG8_BAR;
            }
        }
        if constexpr (ALIGN_EPI) { if (wr == 0) PG8_BAR; }
        if constexpr (!Epi::AFTER_DRAIN) { E(acc, cur, wr, wc, fr, fq); S.done(cur); }
        if (!has_next) break;
#pragma unroll
        for (int a = 0; a < 2; ++a)
#pragma unroll
            for (int b = 0; b < 2; ++b)
#pragma unroll
                for (int m = 0; m < 4; ++m)
#pragma unroll
                    for (int n = 0; n < 2; ++n) acc[a][b][m][n] = (f32x4){0.f, 0.f, 0.f, 0.f};
        cur = nxt; cA = nA; cB = nB; ++ui;
        if constexpr (ALIGN_EPI) { if (wr == 1) PG8_BAR; }
    }
    PG8_WAIT_V(0);
    if constexpr (!ALIGN_EPI) { if (wr == 0) PG8_BAR; }
    PG8_BAR;
    if constexpr (Epi::AFTER_DRAIN) { E.fused(acc, cur, wr, wc, fr, fq, lds, wid, lane); S.done(cur); }
#undef PG8_SA
#undef PG8_SB
#undef PG8_STAGE
#undef PG8_LDA
#undef PG8_LDB
#undef PG8_MMA
#undef PG8_WAIT_V
#undef PG8_WAIT_L
#undef PG8_BAR
#undef PG8_SCHED
}
}

namespace pg8 {
struct EpiF32 {
    static constexpr bool PERM = false, AFTER_DRAIN = false;
    float* C; int ldc;
    __device__ __forceinline__ void operator()(const f32x4 (&acc)[2][2][4][2], const Unit& u, int wr, int wc, int fr, int fq) const {
        const int row0 = u.pm * BM + wr * 64 + fr, col0 = u.pn * BM + wc * 32 + 4 * fq;
#pragma unroll
        for (int ai = 0; ai < 2; ++ai)
#pragma unroll
            for (int m = 0; m < 4; ++m) { float* rowp = C + (size_t)(row0 + ai * HALF + m * 16) * ldc + col0;
#pragma unroll
                for (int bj = 0; bj < 2; ++bj)
#pragma unroll
                    for (int n = 0; n < 2; ++n) *(f32x4*)(rowp + bj * HALF + n * 16) = acc[ai][bj][m][n]; }
    }
};
struct EpiZ {
    static constexpr bool PERM = true, AFTER_DRAIN = false;
    bf16_t* Z; float* out;
    __device__ __forceinline__ void operator()(const f32x4 (&acc)[2][2][4][2], const Unit& u, int wr, int wc, int fr, int fq) const {
        const int row0 = u.pm * BM + wr * 64 + fr, col0 = u.pn * BM + wc * 32 + 8 * fq;
        const bool kvt = (u.pn >= 2 && u.pn <= 5) && (u.pm >= 56);
        float* wbase = nullptr; int kc0 = 0;
        if (kvt) { const bool isk = u.pn < 4, smp = u.pm == 64; kc0 = col0 - (isk ? 512 : 1024); size_t off = smp ? (size_t)19213828 : (size_t)17039360; if (!isk) off += smp ? (size_t)33554432 : (size_t)1048576; wbase = out + off; }
#pragma unroll
        for (int ai = 0; ai < 2; ++ai)
#pragma unroll
            for (int m = 0; m < 4; ++m) { const int row = row0 + ai * HALF + m * 16; bf16_t* rowp = Z + (size_t)row * 3584 + col0;
                size_t wrow = 0;
                if (kvt) { if (u.pm == 64) { const int sr = row - 16384; wrow = (size_t)((sr >> 3) * 2048 + 2040 + (sr & 7)); } else wrow = (size_t)(row - 14336); }
#pragma unroll
                for (int bj = 0; bj < 2; ++bj) { const f32x4 v0 = acc[ai][bj][m][0], v1 = acc[ai][bj][m][1];
                    u32x4 w; w.x = cvt_pk_bf16(v0[0], v0[1]); w.y = cvt_pk_bf16(v0[2], v0[3]); w.z = cvt_pk_bf16(v1[0], v1[1]); w.w = cvt_pk_bf16(v1[2], v1[3]);
                    *(u32x4*)(rowp + bj * HALF) = w;
                    if (kvt) { float* d = wbase + wrow * 512 + kc0 + bj * HALF; *(f32x4*)d = v0; *(f32x4*)(d + 4) = v1; } } }
    }
};
}

constexpr int NWAVES = 8;
constexpr int TP = 16384, TS = 256, MALL = TP + TS, DM = 1024, NZ = 3584, NIN = 3592, DFF = 2816, NUP = 5632;
constexpr float RMS_EPS = 1e-6f;
constexpr float LOG2E = 1.4426950408889634f;
constexpr float QSCALE = 0.125f * LOG2E;
constexpr float KMSCALE = 0.08838834764831845f;
constexpr int ZQA = 0, ZKA = 512, ZVA = 1024, ZQM = 1536, ZKM = 2048, ZVM = 2560, ZOM = 3072;
constexpr size_t O_YP = 0, O_YS = 16777216, O_KWP = 17039360, O_VWP = 18087936, O_CP = 19136512, O_NP = 19202048, O_MP = 19202560, O_CONVP = 19202564,
    O_KWS = 19213828, O_VWS = 52768260, O_CS = 86322692, O_NS = 88419844, O_MS = 88436228, O_CONVS = 88436356, O_END = 88796804;
constexpr size_t MiB = 1u << 20;
constexpr size_t WS_CTL = 0, CTL_ZERO_BYTES = 1 * MiB;
constexpr size_t WS_WIN = 2 * MiB, WS_WOUT = 10 * MiB, WS_WUP = 12 * MiB, WS_WDN = 24 * MiB;
constexpr size_t WS_G = 30 * MiB, WS_GB = 31 * MiB, WS_CS = 32 * MiB, WS_BT = 32 * MiB + 131072, WS_LSE = 33 * MiB, WS_DN = 35 * MiB, WS_NSNAP = 35 * MiB + 524288;
constexpr size_t WS_XN = 36 * MiB, WS_Z = 72 * MiB, WS_PART = 192 * MiB, WS_DC = 244 * MiB, WS_CSNAP = 278 * MiB, WS_MIX = 296 * MiB, WS_MIXED = 332 * MiB, WS_END = 402 * MiB;
constexpr size_t WS_U = 72 * MiB, WS_ACT = 296 * MiB, WS_Y = 72 * MiB;
static_assert(WS_XN + (size_t)MALL * DM * 2 <= WS_Z && WS_Z + (size_t)MALL * NZ * 2 <= WS_PART && WS_PART + (size_t)3 * TP * 512 * 2 <= WS_DC && WS_DC + (size_t)512 * 16384 * 4 <= WS_CSNAP
              && WS_CSNAP + (size_t)512 * 16384 * 2 <= WS_MIX && WS_MIX + (size_t)MALL * DM * 2 <= WS_MIXED && WS_MIXED + (size_t)MALL * DM * 4 <= WS_END
              && WS_U + (size_t)MALL * NUP * 2 <= WS_MIX && WS_ACT + (size_t)MALL * DFF * 2 <= WS_END && WS_Y + (size_t)MALL * DM * 4 <= WS_MIX, "d_ws map");
constexpr int CW_TMO = 0, CW_CODE = 1, CW_BAR = 4096;
constexpr int RING_OFF = 0, RING_BYTES = 131072, LDSCTL_OFF = RING_BYTES, MISC_OFF = LDSCTL_OFF + 320, LDS_BYTES = 147456;
constexpr int MS_OFF = 122880;

#define GAS __attribute__((address_space(1)))
#define LAS __attribute__((address_space(3)))
typedef unsigned short bf16;
typedef unsigned v4u __attribute__((ext_vector_type(4)));
typedef float f32x4 __attribute__((ext_vector_type(4)));
typedef short bf16x8 __attribute__((ext_vector_type(8)));
typedef GAS unsigned gu32;
typedef GAS unsigned long long gu64;
#define RLX_AGENT __ATOMIC_RELAXED, __HIP_MEMORY_SCOPE_AGENT
#define LDS_WAIT() asm volatile("s_waitcnt lgkmcnt(0)" ::: "memory")
#define VM_WAIT() asm volatile("s_waitcnt vmcnt(0)" ::: "memory")
__device__ __forceinline__ unsigned long long rt() { return __builtin_amdgcn_s_memrealtime(); }
__device__ __forceinline__ unsigned f2bf(float f) { unsigned u = __builtin_bit_cast(unsigned, f); return (u + 0x7fffu + ((u >> 16) & 1u)) >> 16; }
__device__ __forceinline__ unsigned pk2(float lo, float hi) { return f2bf(lo) | (f2bf(hi) << 16); }

#define XB_TMO      128
#define XB_XCNT(j)  (256  + 64 * (j))
#define XB_XSUB(j)  (1280 + 64 * (j))
#define XB_XGEN(j)  (2304 + 64 * (j))
#define XB_TOP      3328
#define XB_TOPGEN   3392
#define XCD_BAR_WORDS 3456
#define XB_SPIN_CAP (1u << 18)

__device__ __forceinline__ unsigned xb_ld(unsigned* p)              { return __hip_atomic_load(p, __ATOMIC_RELAXED, __HIP_MEMORY_SCOPE_AGENT); }
__device__ __forceinline__ unsigned xb_add(unsigned* p, unsigned v) { return __hip_atomic_fetch_add(p, v, __ATOMIC_RELAXED, __HIP_MEMORY_SCOPE_AGENT); }
__device__ __forceinline__ unsigned xb_xcc_id() { return (unsigned)__builtin_amdgcn_s_getreg((3 << 11) | 20) & 0xFu; }
#define XB_SPIN(cond, bar) do { unsigned _sp = 0; while (cond) { __builtin_amdgcn_s_sleep(1); \
    if ((++_sp & 255u) == 0u) { if (xb_ld(&(bar)[XB_TMO])) break; if (_sp > XB_SPIN_CAP) { atomicAdd(&(bar)[XB_TMO], 1u); break; } } } } while (0)

struct XcdBarrier {
    unsigned* bar; unsigned x;
    volatile LAS unsigned* st;
};

__device__ __forceinline__ XcdBarrier xcd_barrier_post(unsigned* bar, volatile LAS unsigned* st) {
    XcdBarrier b; b.bar = bar; b.x = xb_xcc_id(); b.st = st;
    if (threadIdx.x == 0) (void)xb_add(&bar[XB_XCNT(b.x)], 1u);
    return b;
}
__device__ __forceinline__ void xcd_barrier_complete(unsigned* bar, unsigned x, unsigned& nloc, unsigned& nx) {
    const unsigned G = gridDim.x * gridDim.y * gridDim.z;
    unsigned sum, cnt, mine, sp = 0u;
    for (;;) {
        sum = 0u; cnt = 0u; mine = 0u;
#pragma unroll
        for (unsigned j = 0; j < 16; ++j) { const unsigned c = xb_ld(&bar[XB_XCNT(j)]); sum += c; cnt += (c > 0u) ? 1u : 0u; mine = (j == x) ? c : mine; }
        if (sum == G) break;
        __builtin_amdgcn_s_sleep(1);
        if ((++sp & 255u) == 0u) { if (xb_ld(&bar[XB_TMO])) break; if (sp > XB_SPIN_CAP) { atomicAdd(&bar[XB_TMO], 1u); break; } }
    }
    nloc = mine > 0u ? mine : 1u; nx = cnt > 0u ? cnt : 1u;
}

__device__ __forceinline__ void xcd_barrier(const XcdBarrier& b) {
    asm volatile("s_waitcnt vmcnt(0)" ::: "memory");
    __syncthreads();
    if (threadIdx.x == 0) {
        unsigned* bar = b.bar;
        __builtin_amdgcn_s_waitcnt(0);
        unsigned nloc = b.st[0], nx = b.st[1];
        if (nloc == 0u) { xcd_barrier_complete(bar, b.x, nloc, nx); b.st[0] = nloc; b.st[1] = nx; }
        const unsigned old = xb_add(&bar[XB_XSUB(b.x)], 1u);
        const unsigned gen = old / nloc;
        if (old + 1u == (gen + 1u) * nloc) {
            __builtin_amdgcn_fence(__ATOMIC_RELEASE, "agent");
            asm volatile("s_waitcnt vmcnt(0)" ::: "memory");
            const unsigned og = xb_add(&bar[XB_TOP], 1u);
            const unsigned tg = og / nx;
            if (og + 1u == (tg + 1u) * nx) xb_add(&bar[XB_TOPGEN], 1u);
            else XB_SPIN(xb_ld(&bar[XB_TOPGEN]) == tg, bar);
            __builtin_amdgcn_fence(__ATOMIC_ACQUIRE, "agent");
            xb_add(&bar[XB_XGEN(b.x)], 1u);
            asm volatile("s_waitcnt vmcnt(0)" ::: "memory");
        } else {
            XB_SPIN(xb_ld(&bar[XB_XGEN(b.x)]) == gen, bar);
            __builtin_amdgcn_fence(__ATOMIC_ACQUIRE, "agent");
            asm volatile("s_waitcnt vmcnt(0)" ::: "memory");
        }
    }
    __syncthreads();
}


typedef short s16x4 __attribute__((ext_vector_type(4)));
typedef unsigned v2u __attribute__((ext_vector_type(2)));
typedef float f32x2 __attribute__((ext_vector_type(2)));
__device__ __forceinline__ float bf2f(unsigned short b) { return __uint_as_float((unsigned)b << 16); }
__device__ __forceinline__ float bflo(unsigned w) { return __uint_as_float(w << 16); }
__device__ __forceinline__ float bfhi(unsigned w) { return __uint_as_float(w & 0xffff0000u); }
__device__ __forceinline__ float ex2(float x) { return __builtin_amdgcn_exp2f(x); }
__device__ __forceinline__ float fexp(float x) { return __builtin_amdgcn_exp2f(x * LOG2E); }
__device__ __forceinline__ s16x4 tr_read(const LAS unsigned char* p) {
    typedef short v4i16_t __attribute__((ext_vector_type(4)));
    return __builtin_bit_cast(s16x4, __builtin_amdgcn_ds_read_tr16_b64_v4i16((LAS v4i16_t*)p)); }
__device__ __forceinline__ bf16x8 cat4(s16x4 lo, s16x4 hi) { return (bf16x8){lo[0], lo[1], lo[2], lo[3], hi[0], hi[1], hi[2], hi[3]}; }
__device__ __forceinline__ bf16x8 pack8(f32x4 a, f32x4 b) {
    v4u w; w.x = pk2(a[0], a[1]); w.y = pk2(a[2], a[3]); w.z = pk2(b[0], b[1]); w.w = pk2(b[2], b[3]); return __builtin_bit_cast(bf16x8, w); }
#define MFMA16(a, b, c) __builtin_amdgcn_mfma_f32_16x16x32_bf16((a), (b), (c), 0, 0, 0)

struct Frame {
    LAS unsigned char* lds;
    volatile LAS unsigned* MISC;
    gu32* ctl;
    int tid, lane, wave, vcu, G;
    const float *xp, *xs, *cache_k, *cache_v, *st_C, *st_n, *st_m, *st_conv, *rel_bias, *g_pre, *w_in, *b_i, *b_f, *g_ml, *w_out, *g_post, *g_ffn, *w_up, *conv_w, *conv_b, *w_down, *g_fpost;
    float* out;
    bf16 *Win_t, *Wout_t, *Wup_t, *Wdn_t, *XN, *Z, *PART, *CSNAP, *MIX, *U, *ACT;
    float *Gt, *GB, *CS, *BT, *LSE, *DN, *NSNAP, *DC, *MIXED, *Y;
};

__device__ __forceinline__ float wave_sum(float v) {
#pragma unroll
    for (int o = 1; o < 64; o <<= 1) v += __shfl_xor(v, o);
    return v;
}

__device__ __forceinline__ void p0_transpose_item(const float* W, int ldw, int Kd, bf16* WT, LAS float* scr, int k0, int n0, int drow0, float scale, int lane) {
#pragma unroll 8
    for (int i = 0; i < 32; ++i) { const int kk = 2 * i + (lane >> 5); scr[kk * 33 + (lane & 31)] = W[(size_t)(k0 + kk) * ldw + n0 + (lane & 31)] * scale; }
    LDS_WAIT(); asm volatile("" ::: "memory");
    const int c = lane & 7;
#pragma unroll
    for (int j = 0; j < 4; ++j) { const int n = (lane >> 3) + 8 * j; const LAS float* s = scr + (8 * c) * 33 + n;
        v4u o; o.x = pk2(s[0 * 33], s[1 * 33]); o.y = pk2(s[2 * 33], s[3 * 33]); o.z = pk2(s[4 * 33], s[5 * 33]); o.w = pk2(s[6 * 33], s[7 * 33]);
        *(GAS v4u*)(WT + (size_t)(drow0 + n) * Kd + k0 + 8 * c) = o; }
    LDS_WAIT(); asm volatile("" ::: "memory");
}
__device__ __forceinline__ float logsigmoidf(float x) { return fminf(x, 0.f) - log1pf(__expf(-fabsf(x))); }

__device__ __forceinline__ void p0_prologue(Frame& F) {
    const int gw = F.vcu * NWAVES + F.wave, NGW = F.G * NWAVES, lane = F.lane;
    {
        LAS float* Wg = (LAS float*)(F.lds);
        for (int i = F.tid; i < 8192; i += NWAVES * 64) { const int j = i >> 10, k = i & 1023; Wg[i] = F.g_pre[k] * F.w_in[(size_t)k * NIN + 3584 + j]; }
        __syncthreads();
        f32x4 gp[4];
#pragma unroll
        for (int j = 0; j < 4; ++j) gp[j] = *(const f32x4*)(F.g_pre + 256 * j + 4 * lane);
        for (int m = gw; m < MALL; m += NGW) {
            const float* xrow = m < TP ? F.xp + (size_t)m * DM : F.xs + (size_t)(m - TP) * DM;
            f32x4 v[4]; float s = 0.f;
#pragma unroll
            for (int j = 0; j < 4; ++j) { v[j] = *(const f32x4*)(xrow + 256 * j + 4 * lane); s += (v[j].x * v[j].x + v[j].y * v[j].y) + (v[j].z * v[j].z + v[j].w * v[j].w); }
            const float rs = rsqrtf(wave_sum(s) * (1.f / DM) + RMS_EPS);
            float ga[8];
#pragma unroll
            for (int i = 0; i < 8; ++i) { float a = 0.f;
#pragma unroll
                for (int j = 0; j < 4; ++j) { const f32x4 w = *(const LAS f32x4*)(Wg + i * 1024 + 256 * j + 4 * lane); a += (v[j].x * w.x + v[j].y * w.y) + (v[j].z * w.z + v[j].w * w.w); }
                ga[i] = wave_sum(a) * rs; }
            if (lane == 0) {
                f32x4 o0, o1;
#pragma unroll
                for (int i = 0; i < 4; ++i) { o0[i] = ga[i] + F.b_i[i]; o1[i] = logsigmoidf(ga[4 + i] + F.b_f[i]); }
                *(f32x4*)(F.Gt + (size_t)m * 8) = o0; *(f32x4*)(F.Gt + (size_t)m * 8 + 4) = o1;
            }
            bf16* orow = F.XN + (size_t)m * DM;
#pragma unroll
            for (int j = 0; j < 4; ++j) { v2u o; o.x = pk2(v[j].x * rs * gp[j].x, v[j].y * rs * gp[j].y); o.y = pk2(v[j].z * rs * gp[j].z, v[j].w * rs * gp[j].w); *(v2u*)(orow + 256 * j + 4 * lane) = o; }
        }
        __syncthreads();
    }
    {
        LAS float* scr = (LAS float*)(F.lds + RING_OFF + F.wave * 16384);
        constexpr int I_IN = 16 * 112, I_OUT = 16 * 32, I_UP = 16 * 176, I_DN = 44 * 32, NITEMS = I_IN + I_OUT + I_UP + I_DN;
        for (int it = gw; it < NITEMS; it += NGW) {
            int r = it;
            if (r < I_IN) { const int kb = r / 112, nb = r % 112, n0 = 32 * nb; const float sc = n0 < 512 ? QSCALE : ((n0 >= ZKM && n0 < ZVM) ? KMSCALE : 1.f);
                p0_transpose_item(F.w_in, NIN, DM, F.Win_t, scr, 64 * kb, n0, n0, sc, lane); continue; } r -= I_IN;
            if (r < I_OUT) { const int kb = r / 32, nb = r % 32; p0_transpose_item(F.w_out, DM, DM, F.Wout_t, scr, 64 * kb, 32 * nb, 32 * nb, 1.f, lane); continue; } r -= I_OUT;
            if (r < I_UP) { const int kb = r / 176, nb = r % 176, n0 = 32 * nb; const int nn = n0 < DFF ? n0 : n0 - DFF; const int drow = 256 * (nn >> 7) + (nn & 127) + (n0 < DFF ? 0 : 128);
                p0_transpose_item(F.w_up, NUP, DM, F.Wup_t, scr, 64 * kb, n0, drow, 1.f, lane); continue; } r -= I_UP;
            { const int kb = r / 32, nb = r % 32; p0_transpose_item(F.w_down, DM, DFF, F.Wdn_t, scr, 64 * kb, 32 * nb, 32 * nb, 1.f, lane); }
        }
    }
    {
        constexpr int SEG = 2040 * 512 / 4, CH = 6 * 512, NCH = (SEG / CH) * 64;
        static_assert(SEG % CH == 0, "copy chunking");
        for (int chk = F.vcu; chk < NCH; chk += F.G) {
            const int seg = chk / (SEG / CH), off = (chk % (SEG / CH)) * CH + F.tid, b = seg & 31; const bool isv = seg >= 32;
            const f32x4* src = (const f32x4*)((isv ? F.cache_v : F.cache_k) + (size_t)b * 2048 * 512 + 8 * 512) + off;
            f32x4* dst = (f32x4*)(F.out + (isv ? O_VWS : O_KWS) + (size_t)b * 2048 * 512) + off;
            f32x4 t[6];
#pragma unroll
            for (int i = 0; i < 6; ++i) t[i] = __builtin_nontemporal_load(src + 512 * i);
#pragma unroll
            for (int i = 0; i < 6; ++i) __builtin_nontemporal_store(t[i], dst + 512 * i);
        }
    }
    if (F.vcu == 0) {
        for (int i = F.tid; i < 3 * 8 * 132; i += NWAVES * 64) {
            const int g = i / (8 * 132), h = (i / 132) % 8, j = i % 132; float val = 0.f;
            if (j <= 128) { const int dist = j << (2 * g); int bk;
                if (dist < 16) bk = dist; else { bk = 16 + (int)(logf((float)dist * (1.f / 16.f)) / logf(128.f) * 16.f); if (bk > 31) bk = 31; }
                val = F.rel_bias[bk * 8 + h] * LOG2E; }
            F.BT[i] = val;
        }
    }
}

__device__ __forceinline__ void chunk_stats(Frame& F) {
    LAS float* sc = (LAS float*)F.lds;
    for (int c = F.vcu; c < 128; c += F.G) {
        const int h = F.tid >> 7, s = F.tid & 127; const size_t row = (size_t)128 * c + s;
        const float lf = F.Gt[row * 8 + 4 + h], ig = F.Gt[row * 8 + h];
        sc[F.tid] = lf; __syncthreads();
        int cur = 0;
        for (int off = 1; off < 128; off <<= 1) { float v = sc[cur * 512 + F.tid]; if (s >= off) v += sc[cur * 512 + F.tid - off]; sc[(cur ^ 1) * 512 + F.tid] = v; __syncthreads(); cur ^= 1; }
        const float b = sc[cur * 512 + F.tid], u = ig - b;
        F.GB[row * 8 + h] = b; F.GB[row * 8 + 4 + h] = u;
        __syncthreads();
        sc[F.tid] = u; __syncthreads();
        for (int off = 64; off >= 1; off >>= 1) { if (s < off) sc[F.tid] = fmaxf(sc[F.tid], sc[F.tid + off]); __syncthreads(); }
        if (s == 127) F.CS[(c * 4 + h) * 2] = b;
        if (s == 0) F.CS[(c * 4 + h) * 2 + 1] = sc[F.tid];
        __syncthreads();
    }
}
__device__ __forceinline__ void mscan_to_lds(Frame& F, LAS float* ms) {
    if (F.wave < 4) {
        const int h = F.wave, l = F.lane;
        const float A0 = F.CS[((2 * l) * 4 + h) * 2], B0 = A0 + F.CS[((2 * l) * 4 + h) * 2 + 1];
        const float A1 = F.CS[((2 * l + 1) * 4 + h) * 2], B1 = A1 + F.CS[((2 * l + 1) * 4 + h) * 2 + 1];
        float PA = A0 + A1, PB = fmaxf(B0 + A1, B1);
#pragma unroll
        for (int off = 1; off < 64; off <<= 1) { const float a = __shfl_up(PA, off), b = __shfl_up(PB, off); if (l >= off) { PB = fmaxf(b + PA, PB); PA = a + PA; } }
        float EA = __shfl_up(PA, 1), EB = __shfl_up(PB, 1); if (l == 0) { EA = 0.f; EB = -INFINITY; }
        const float m0 = fmaxf(EA, EB), m1 = fmaxf(m0 + A0, B0);
        ms[h * 132 + 2 * l] = m0; ms[h * 132 + 2 * l + 1] = m1;
        if (l == 63) ms[h * 132 + 128] = fmaxf(m1 + A1, B1);
    }
    __syncthreads();
}

struct AttnRegs { v4u k[4], v[4]; };
__device__ __forceinline__ void attn_load(Frame& F, int a, AttnRegs& R) {
    const int h = a & 7, rn = (a >> 3) & 127, g = a >> 10, sh = 2 * g, nb = 128 >> sh, r = rn >> (7 - sh), n = rn & (nb - 1);
#pragma unroll
    for (int i = 0; i < 4; ++i) {
        const int c = F.tid + 512 * i, row = c >> 3, ch = c & 7, mk = 128 * (n - 1) + row;
        R.k[i] = (v4u){0u, 0u, 0u, 0u}; R.v[i] = (v4u){0u, 0u, 0u, 0u};
        if (mk >= 0) { const size_t tok = ((size_t)mk << sh) + r; const bf16* p = F.Z + tok * NZ + h * 64 + ch * 8; R.k[i] = *(const v4u*)(p + ZKA); R.v[i] = *(const v4u*)(p + ZVA); }
    }
}
__device__ __forceinline__ void attn_stage(Frame& F, int a, const AttnRegs& R) {
    const int h = a & 7, g = a >> 10;
    LAS unsigned char* KT = F.lds; LAS unsigned char* VT = F.lds + 40960; LAS float* BTl = (LAS float*)(F.lds + 81920);
#pragma unroll
    for (int i = 0; i < 4; ++i) { const int c = F.tid + 512 * i, row = c >> 3, ch = c & 7;
        *(LAS v4u*)(KT + row * 160 + ch * 16) = R.k[i]; *(LAS v4u*)(VT + row * 160 + ch * 16) = R.v[i]; }
    if (F.tid < 192) { const int st = F.tid - 32; BTl[F.tid] = (st >= 0 && st <= 128) ? F.BT[(g * 8 + h) * 132 + st] : -1e30f; }
}
__device__ __forceinline__ void attn_qload(Frame& F, int a, bf16x8& qf0, bf16x8& qf1) {
    const int h = a & 7, rn = (a >> 3) & 127, g = a >> 10, sh = 2 * g, nb = 128 >> sh, r = rn >> (7 - sh), n = rn & (nb - 1);
    const int qi = 16 * F.wave + (F.lane & 15), G = F.lane >> 4;
    const size_t qtok = ((size_t)(128 * n + qi) << sh) + r;
    qf0 = *(const bf16x8*)(F.Z + qtok * NZ + h * 64 + G * 8); qf1 = *(const bf16x8*)(F.Z + qtok * NZ + h * 64 + 32 + G * 8);
}
__device__ __forceinline__ void attn_compute(Frame& F, int a, const bf16x8 qf0, const bf16x8 qf1) {
    const int h = a & 7, rn = (a >> 3) & 127, g = a >> 10, sh = 2 * g, nb = 128 >> sh, r = rn >> (7 - sh), n = rn & (nb - 1);
    LAS unsigned char* KT = F.lds; LAS unsigned char* VT = F.lds + 40960; LAS float* BTl = (LAS float*)(F.lds + 81920);
    int w = F.wave; asm volatile("" : "+s"(w));
    const int lane = F.lane, q = lane & 15, G = lane >> 4, b0 = w < 7 ? w : 6, qi = 16 * w + q;
    const size_t qtok = ((size_t)(128 * n + qi) << sh) + r;
    f32x4 s[10];
#pragma unroll
    for (int blk = 0; blk < 10; ++blk) {
        const LAS unsigned char* kp = KT + (16 * (b0 + blk) + q) * 160 + G * 16;
        const bf16x8 k0 = *(const LAS bf16x8*)kp, k1 = *(const LAS bf16x8*)(kp + 64);
        f32x4 z = {0.f, 0.f, 0.f, 0.f};
        z = MFMA16(k0, qf0, z); s[blk] = MFMA16(k1, qf1, z);
    }
    const int base = 128 + qi - 16 * b0 - 4 * G + 32;
    float mx = -3e38f;
#pragma unroll
    for (int blk = 0; blk < 10; ++blk)
#pragma unroll
        for (int rg = 0; rg < 4; ++rg) {
            float sv = s[blk][rg] + BTl[base - 16 * blk - rg];
            if (n == 0 && (16 * (b0 + blk) + 4 * G + rg) < 128) sv = -1e30f;
            s[blk][rg] = sv; mx = fmaxf(mx, sv); }
    mx = fmaxf(mx, __shfl_xor(mx, 16)); mx = fmaxf(mx, __shfl_xor(mx, 32));
    float l = 0.f;
#pragma unroll
    for (int blk = 0; blk < 10; ++blk)
#pragma unroll
        for (int rg = 0; rg < 4; ++rg) { const float p = ex2(s[blk][rg] - mx); s[blk][rg] = p; l += p; }
    l += __shfl_xor(l, 16); l += __shfl_xor(l, 32);
    f32x4 o[4];
#pragma unroll
    for (int eb = 0; eb < 4; ++eb) o[eb] = (f32x4){0.f, 0.f, 0.f, 0.f};
    const int q4 = q >> 2, p4 = q & 3;
#pragma unroll
    for (int st = 0; st < 5; ++st) {
        const bf16x8 pb = pack8(s[2 * st], s[2 * st + 1]);
        const LAS unsigned char* vb = VT + (16 * (b0 + 2 * st) + 4 * G + q4) * 160 + 8 * p4;
#pragma unroll
        for (int eb = 0; eb < 4; ++eb) { const s16x4 lo = tr_read(vb + 32 * eb), hi = tr_read(vb + 32 * eb + 16 * 160); o[eb] = MFMA16(cat4(lo, hi), pb, o[eb]); }
    }
    const float inv = 1.f / l;
    bf16* P = F.PART + ((size_t)g * TP + qtok) * 512 + h * 64 + 4 * G;
#pragma unroll
    for (int eb = 0; eb < 4; ++eb) { v2u ov; ov.x = pk2(o[eb][0] * inv, o[eb][1] * inv); ov.y = pk2(o[eb][2] * inv, o[eb][3] * inv); *(v2u*)(P + 16 * eb) = ov; }
    if (G == 0) F.LSE[((size_t)g * TP + qtok) * 8 + h] = mx + __log2f(l);
}

__device__ __forceinline__ void dc_unit(Frame& F, int cu, const LAS float* ms) {
    const int c = cu >> 2, h = cu & 3;
    LAS unsigned char* KT = F.lds; LAS unsigned char* VT = F.lds + 36864; LAS float* WSl = (LAS float*)(F.lds + 73728); LAS float* RED = WSl + 128;
    const float bL = F.CS[(c * 4 + h) * 2], mnext = ms[h * 132 + c + 1];
    if (F.tid < 128) WSl[F.tid] = fexp(bL + F.GB[((size_t)128 * c + F.tid) * 8 + 4 + h] - mnext);
    __syncthreads();
#pragma unroll
    for (int i = 0; i < 4; ++i) {
        const int ci = F.tid + 512 * i, row = ci >> 4, ch = ci & 15; const bf16* p = F.Z + ((size_t)128 * c + row) * NZ + 128 * h + ch * 8;
        const v4u kk = *(const v4u*)(p + ZKM), vv = *(const v4u*)(p + ZVM); const float wsv = WSl[row];
        v4u vo; vo.x = pk2(bflo(vv.x) * wsv, bfhi(vv.x) * wsv); vo.y = pk2(bflo(vv.y) * wsv, bfhi(vv.y) * wsv); vo.z = pk2(bflo(vv.z) * wsv, bfhi(vv.z) * wsv); vo.w = pk2(bflo(vv.w) * wsv, bfhi(vv.w) * wsv);
        *(LAS v4u*)(KT + row * 288 + ch * 16) = kk; *(LAS v4u*)(VT + row * 288 + ch * 16) = vo;
    }
    __syncthreads();
    int w = F.wave; asm volatile("" : "+s"(w));
    const int lane = F.lane, col = lane & 15, G = lane >> 4, q4 = col >> 2, p4 = col & 3;
    f32x4 acc[8];
#pragma unroll
    for (int kb = 0; kb < 8; ++kb) acc[kb] = (f32x4){0.f, 0.f, 0.f, 0.f};
#pragma unroll
    for (int ks = 0; ks < 4; ++ks) {
        const int srow = 32 * ks + 8 * G + q4;
        const LAS unsigned char* ap = VT + srow * 288 + (16 * w + 4 * p4) * 2;
        const bf16x8 A = cat4(tr_read(ap), tr_read(ap + 4 * 288));
        const LAS unsigned char* bp = KT + srow * 288 + 8 * p4;
#pragma unroll
        for (int kb = 0; kb < 8; ++kb) { const bf16x8 B = cat4(tr_read(bp + 32 * kb), tr_read(bp + 32 * kb + 4 * 288)); acc[kb] = MFMA16(A, B, acc[kb]); }
    }
    float* D = F.DC + ((size_t)(c * 4 + h) << 14);
#pragma unroll
    for (int kb = 0; kb < 8; ++kb)
#pragma unroll
        for (int rg = 0; rg < 4; ++rg) D[(16 * w + 4 * G + rg) * 128 + 16 * kb + col] = acc[kb][rg];
    { const int k = F.tid & 127, part = F.tid >> 7; float sm = 0.f;
#pragma unroll 8
      for (int s = 0; s < 32; ++s) sm += WSl[32 * part + s] * bf2f(*(const LAS unsigned short*)(KT + (32 * part + s) * 288 + k * 2));
      RED[part * 128 + k] = sm; }
    __syncthreads();
    if (F.tid < 128) F.DN[(c * 4 + h) * 128 + F.tid] = (RED[F.tid] + RED[128 + F.tid]) + (RED[256 + F.tid] + RED[384 + F.tid]);
    __syncthreads();
}

__device__ __forceinline__ void sattn_unit(Frame& F, int u) {
    int t = F.wave; asm volatile("" : "+s"(t));
    const int b = u >> 3, h = u & 7, lane = F.lane, sub = lane >> 4, dq = lane & 15;
    LAS float* SCl = (LAS float*)(F.lds) + t * 400 + sub * 100;
    const size_t row = (size_t)TP + 8 * b + t;
    const v2u qw = *(const v2u*)(F.Z + row * NZ + h * 64 + 4 * dq);
    const f32x4 q4 = {bflo(qw.x), bfhi(qw.x), bflo(qw.y), bfhi(qw.y)};
    const float* ck = F.cache_k + ((size_t)b * 2048 * 8 + h) * 64 + 4 * dq; const float* cv = F.cache_v + ((size_t)b * 2048 * 8 + h) * 64 + 4 * dq;
    const float* nk = F.out + O_KWS + (((size_t)b * 2048 + 2040) * 8 + h) * 64 + 4 * dq; const float* nv = F.out + O_VWS + (((size_t)b * 2048 + 2040) * 8 + h) * 64 + 4 * dq;
    float mx = -3e38f;
    for (int g = 0; g < 3; ++g) {
        const float* bt = F.BT + (g * 8 + h) * 132;
        for (int i0 = 0; i0 < 33; i0 += 11) {
            f32x4 k4[11];
#pragma unroll
            for (int i = 0; i < 11; ++i) { const int j = 4 * (i0 + i) + sub, jc = j > 128 ? 128 : j, idx = 2048 + t - (jc << (2 * g));
                k4[i] = *(const f32x4*)(idx < 2048 ? ck + (size_t)idx * 512 : nk + (size_t)(idx - 2048) * 512); }
#pragma unroll
            for (int i = 0; i < 11; ++i) { const int j = 4 * (i0 + i) + sub, jc = j > 128 ? 128 : j;
                float d = (q4.x * k4[i].x + q4.y * k4[i].y) + (q4.z * k4[i].z + q4.w * k4[i].w);
                d += __shfl_xor(d, 1); d += __shfl_xor(d, 2); d += __shfl_xor(d, 4); d += __shfl_xor(d, 8);
                const float sv = (j <= 128) ? d + bt[jc] : -1e30f;
                if (dq == 0) SCl[g * 33 + i0 + i] = sv;
                mx = fmaxf(mx, sv); }
        }
    }
    mx = fmaxf(mx, __shfl_xor(mx, 16)); mx = fmaxf(mx, __shfl_xor(mx, 32));
    float l = 0.f; f32x4 o = {0.f, 0.f, 0.f, 0.f};
    for (int g = 0; g < 3; ++g) {
        for (int i0 = 0; i0 < 33; i0 += 11) {
            f32x4 v4[11];
#pragma unroll
            for (int i = 0; i < 11; ++i) { const int j = 4 * (i0 + i) + sub, jc = j > 128 ? 128 : j, idx = 2048 + t - (jc << (2 * g));
                v4[i] = *(const f32x4*)(idx < 2048 ? cv + (size_t)idx * 512 : nv + (size_t)(idx - 2048) * 512); }
#pragma unroll
            for (int i = 0; i < 11; ++i) { const float p = ex2(SCl[g * 33 + i0 + i] - mx); l += p; o += v4[i] * p; }
        }
    }
    l += __shfl_xor(l, 16); l += __shfl_xor(l, 32);
#pragma unroll
    for (int e = 0; e < 4; ++e) { o[e] += __shfl_xor(o[e], 16); o[e] += __shfl_xor(o[e], 32); }
    if (sub == 0) { const float inv = 1.f / l; v2u ov; ov.x = pk2(o.x * inv, o.y * inv); ov.y = pk2(o.z * inv, o.w * inv); *(v2u*)(F.MIX + row * DM + h * 64 + 4 * dq) = ov; }
    __syncthreads();
}

__device__ __forceinline__ void smlstm_unit(Frame& F, int u) {
    int w = F.wave; asm volatile("" : "+s"(w));
    const int b = u >> 2, h = u & 3, tid = F.tid, lane = F.lane;
    LAS float* QS = (LAS float*)F.lds; LAS float* KS = QS + 1024; LAS float* VS = KS + 1024; LAS float* RED = VS + 1024;
    LAS float* SS = RED + 4096;
    LAS float* QN = SS + 64; LAS float* BTs = QN + 8; LAS float* ITs = BTs + 8;
    const size_t r0 = (size_t)TP + 8 * b;
#pragma unroll
    for (int i = 0; i < 2; ++i) { const int idx = tid + 512 * i, t = idx >> 7, d = idx & 127; const bf16* p = F.Z + (r0 + t) * NZ + 128 * h + d;
        QS[idx] = bf2f(p[ZQM]); KS[idx] = bf2f(p[ZKM]); VS[idx] = bf2f(p[ZVM]); }
    float bt[8], it_[8];
    { float cs = 0.f;
#pragma unroll
      for (int t = 0; t < 8; ++t) { cs += F.Gt[(r0 + t) * 8 + 4 + h]; bt[t] = cs; it_[t] = F.Gt[(r0 + t) * 8 + h]; } }
    const float m0 = F.st_m[b * 4 + h], bL = bt[7];
    float mnew = bL + m0;
#pragma unroll
    for (int s = 0; s < 8; ++s) mnew = fmaxf(mnew, bL - bt[s] + it_[s]);
    float wsv[8];
#pragma unroll
    for (int s = 0; s < 8; ++s) wsv[s] = fexp(bL - bt[s] + it_[s] - mnew);
    const float wc = fexp(bL + m0 - mnew);
    if (tid == 0) {
#pragma unroll
        for (int s = 0; s < 8; ++s) { BTs[s] = bt[s]; ITs[s] = it_[s]; } }
    __syncthreads();
    { const int pair = tid >> 3, part = tid & 7, t = pair >> 3, s = pair & 7; float d = 0.f;
#pragma unroll
      for (int k = 0; k < 16; ++k) d += QS[t * 128 + 16 * part + k] * KS[s * 128 + 16 * part + k];
      d += __shfl_xor(d, 1); d += __shfl_xor(d, 2); d += __shfl_xor(d, 4);
      if (part == 0) SS[pair] = d; }
    { const float* n0 = F.st_n + (size_t)(b * 4 + h) * 128; float d = QS[w * 128 + lane] * n0[lane] + QS[w * 128 + 64 + lane] * n0[64 + lane]; d = wave_sum(d); if (lane == 0) QN[w] = d; }
    const int v = tid & 127, kq = tid >> 7;
    const float* C0 = F.st_C + ((size_t)(b * 4 + h) * 128 + 32 * kq) * 128 + v;
    float* Cn = F.out + O_CS + ((size_t)(b * 4 + h) * 128 + 32 * kq) * 128 + v;
    float pq[8];
#pragma unroll
    for (int t = 0; t < 8; ++t) pq[t] = 0.f;
    float vsw[8];
#pragma unroll
    for (int s = 0; s < 8; ++s) vsw[s] = VS[s * 128 + v] * wsv[s];
#pragma unroll 4
    for (int j = 0; j < 32; ++j) {
        const float cr = C0[(size_t)j * 128]; const int k = 32 * kq + j;
        float cn = wc * cr;
#pragma unroll
        for (int t = 0; t < 8; ++t) { pq[t] += QS[t * 128 + k] * cr; cn += KS[t * 128 + k] * vsw[t]; }
        Cn[(size_t)j * 128] = cn;
    }
#pragma unroll
    for (int t = 0; t < 8; ++t) RED[(kq * 8 + t) * 128 + v] = pq[t];
    if (tid < 128) { float nn = wc * F.st_n[(size_t)(b * 4 + h) * 128 + tid];
#pragma unroll
        for (int s = 0; s < 8; ++s) nn += wsv[s] * KS[s * 128 + tid];
        F.out[O_NS + (size_t)(b * 4 + h) * 128 + tid] = nn; }
    if (tid == 0) F.out[O_MS + b * 4 + h] = mnew;
    __syncthreads();
    {
        const int t = w;
        const float btt = BTs[t];
        float mt = btt + m0;
        for (int s = 0; s <= t; ++s) mt = fmaxf(mt, btt - BTs[s] + ITs[s]);
        float num0 = 0.f, num1 = 0.f, den = 0.f;
        for (int s = 0; s <= t; ++s) { const float sm = SS[t * 8 + s] * fexp(btt - BTs[s] + ITs[s] - mt); den += sm; num0 += sm * VS[s * 128 + lane]; num1 += sm * VS[s * 128 + 64 + lane]; }
        const float iw = fexp(btt + m0 - mt);
        float c0 = 0.f, c1 = 0.f;
#pragma unroll
        for (int kq2 = 0; kq2 < 4; ++kq2) { c0 += RED[(kq2 * 8 + t) * 128 + lane]; c1 += RED[(kq2 * 8 + t) * 128 + 64 + lane]; }
        num0 += iw * c0; num1 += iw * c1; den += iw * QN[t];
        const float inv = 1.f / fmaxf(fabsf(den), fexp(-mt));
        const float h0 = num0 * inv, h1 = num1 * inv;
        const float rs = rsqrtf(wave_sum(h0 * h0 + h1 * h1) * (1.f / 128.f) + RMS_EPS);
        const bf16* om = F.Z + (r0 + t) * NZ + ZOM + 128 * h;
        const float o0 = bf2f(om[lane]), o1 = bf2f(om[64 + lane]);
        bf16* mo = F.MIX + (r0 + t) * DM + 512 + 128 * h;
        mo[lane] = (bf16)f2bf(h0 * rs * F.g_ml[128 * h + lane] / (1.f + __expf(-o0)));
        mo[64 + lane] = (bf16)f2bf(h1 * rs * F.g_ml[128 * h + 64 + lane] / (1.f + __expf(-o1)));
    }
    __syncthreads();
}

__device__ __forceinline__ void p3_scan(Frame& F) {
    LAS float* ms = (LAS float*)(F.lds + MS_OFF);
    LAS float* WC = (LAS float*)F.lds;
    mscan_to_lds(F, ms);
    { const int h = F.tid >> 7, c = F.tid & 127; WC[F.tid] = fexp(F.CS[(c * 4 + h) * 2] + ms[h * 132 + c] - ms[h * 132 + c + 1]); }
    __syncthreads();
    const int gid = F.vcu * (NWAVES * 64) + F.tid;
    if (gid < 65536) {
        const int h = gid >> 14, e = gid & 16383; float C = 0.f;
#pragma unroll 8
        for (int c = 0; c < 128; ++c) { const size_t o = ((size_t)(c * 4 + h) << 14) + e; F.CSNAP[o] = (bf16)f2bf(C); C = WC[h * 128 + c] * C + F.DC[o]; }
        const int v = e >> 7, k = e & 127; F.out[O_CP + (size_t)h * 16384 + k * 128 + v] = C;
    } else if (gid < 65536 + 512) {
        const int j = gid - 65536, h = j >> 7, k = j & 127; float nn = 0.f;
#pragma unroll 8
        for (int c = 0; c < 128; ++c) { const size_t o = (size_t)(c * 4 + h) * 128 + k; F.NSNAP[o] = nn; nn = WC[h * 128 + c] * nn + F.DN[o]; }
        F.out[O_NP + h * 128 + k] = nn;
    } else if (gid < 65536 + 512 + 4) { const int h = gid - 65536 - 512; F.out[O_MP + h] = ms[h * 132 + 128]; }
    __syncthreads();
}

__device__ __forceinline__ void mout_unit(Frame& F, int cu, const LAS float* ms) {
    const int c = cu >> 2, h = cu & 3, tid = F.tid;
    LAS unsigned char* VT = F.lds; LAS float* Ul = (LAS float*)(F.lds + 36864); LAS float* Al = Ul + 128; LAS float* Sc = Al + 128;
    const float mc = ms[h * 132 + c];
#pragma unroll
    for (int i = 0; i < 4; ++i) { const int ci = tid + 512 * i, row = ci >> 4, ch = ci & 15;
        *(LAS v4u*)(VT + row * 288 + ch * 16) = *(const v4u*)(F.Z + ((size_t)128 * c + row) * NZ + ZVM + 128 * h + ch * 8); }
    if (tid < 128) { const float u = F.GB[((size_t)128 * c + tid) * 8 + 4 + h]; Ul[tid] = u; Sc[tid] = u; }
    __syncthreads();
    int cur = 0;
    for (int off = 1; off < 128; off <<= 1) { if (tid < 128) { float v = Sc[cur * 128 + tid]; if (tid >= off) v = fmaxf(v, Sc[cur * 128 + tid - off]); Sc[(cur ^ 1) * 128 + tid] = v; } __syncthreads(); cur ^= 1; }
    if (tid < 128) Al[tid] = fmaxf(mc, Sc[cur * 128 + tid]);
    __syncthreads();
    int w = F.wave; asm volatile("" : "+s"(w));
    const int lane = F.lane, col = lane & 15, G = lane >> 4, q4 = col >> 2, p4 = col & 3;
    const int t = 16 * w + col; const size_t row = (size_t)128 * c + t;
    bf16x8 qf[4];
#pragma unroll
    for (int ks = 0; ks < 4; ++ks) qf[ks] = *(const bf16x8*)(F.Z + row * NZ + ZQM + 128 * h + 32 * ks + 8 * G);
    const float at = Al[t], btv = F.GB[row * 8 + h];
    f32x4 s[8];
#pragma unroll
    for (int sb = 0; sb < 8; ++sb) {
        s[sb] = (f32x4){0.f, 0.f, 0.f, 0.f};
        if (sb <= w) {
            const bf16* kp = F.Z + ((size_t)128 * c + 16 * sb + col) * NZ + ZKM + 128 * h + 8 * G;
#pragma unroll
            for (int ks = 0; ks < 4; ++ks) s[sb] = MFMA16(*(const bf16x8*)(kp + 32 * ks), qf[ks], s[sb]);
        }
    }
    float dl = 0.f;
#pragma unroll
    for (int sb = 0; sb < 8; ++sb) if (sb <= w) {
        const f32x4 u4 = *(const LAS f32x4*)(Ul + 16 * sb + 4 * G);
#pragma unroll
        for (int rg = 0; rg < 4; ++rg) { const int si = 16 * sb + 4 * G + rg; const float wgt = (si <= t) ? fexp(u4[rg] - at) : 0.f; const float v = s[sb][rg] * wgt; s[sb][rg] = v; dl += v; }
    }
    dl += __shfl_xor(dl, 16); dl += __shfl_xor(dl, 32);
    f32x4 nS[8], nC[8];
#pragma unroll
    for (int vb = 0; vb < 8; ++vb) { nS[vb] = (f32x4){0.f, 0.f, 0.f, 0.f}; nC[vb] = (f32x4){0.f, 0.f, 0.f, 0.f}; }
#pragma unroll
    for (int st = 0; st < 4; ++st) if (2 * st <= w) {
        const bf16x8 pb = pack8(s[2 * st], s[2 * st + 1]);
        const LAS unsigned char* vp = VT + (32 * st + 4 * G + q4) * 288 + 8 * p4;
#pragma unroll
        for (int vb = 0; vb < 8; ++vb) nS[vb] = MFMA16(cat4(tr_read(vp + 32 * vb), tr_read(vp + 32 * vb + 16 * 288)), pb, nS[vb]);
    }
    const bf16* Ct = F.CSNAP + ((size_t)(c * 4 + h) << 14);
#pragma unroll
    for (int vb = 0; vb < 8; ++vb)
#pragma unroll
        for (int ks = 0; ks < 4; ++ks) nC[vb] = MFMA16(*(const bf16x8*)(Ct + (16 * vb + col) * 128 + 32 * ks + 8 * G), qf[ks], nC[vb]);
    float qn = 0.f;
    { const float* np = F.NSNAP + (size_t)(c * 4 + h) * 128 + 8 * G;
#pragma unroll
      for (int ks = 0; ks < 4; ++ks) { const f32x4 n0 = *(const f32x4*)(np + 32 * ks), n1 = *(const f32x4*)(np + 32 * ks + 4); const v4u qw = __builtin_bit_cast(v4u, qf[ks]);
          qn += (bflo(qw.x) * n0.x + bfhi(qw.x) * n0.y) + (bflo(qw.y) * n0.z + bfhi(qw.y) * n0.w) + (bflo(qw.z) * n1.x + bfhi(qw.z) * n1.y) + (bflo(qw.w) * n1.z + bfhi(qw.w) * n1.w); } }
    qn += __shfl_xor(qn, 16); qn += __shfl_xor(qn, 32);
    const float iw = fexp(mc - at), den = dl + iw * qn, mt = btv + at, inv = 1.f / fmaxf(fabsf(den), fexp(-mt));
    float ss = 0.f;
#pragma unroll
    for (int vb = 0; vb < 8; ++vb)
#pragma unroll
        for (int rg = 0; rg < 4; ++rg) { const float hv = (nS[vb][rg] + iw * nC[vb][rg]) * inv; nS[vb][rg] = hv; ss += hv * hv; }
    ss += __shfl_xor(ss, 16); ss += __shfl_xor(ss, 32);
    const float rs = rsqrtf(ss * (1.f / 128.f) + RMS_EPS);
#pragma unroll
    for (int vb = 0; vb < 8; ++vb) {
        const int v0 = 16 * vb + 4 * G; const f32x4 gm = *(const f32x4*)(F.g_ml + 128 * h + v0);
        const v2u ow = *(const v2u*)(F.Z + row * NZ + ZOM + 128 * h + v0);
        const float o0 = bflo(ow.x), o1 = bfhi(ow.x), o2 = bflo(ow.y), o3 = bfhi(ow.y);
        v2u r; r.x = pk2(nS[vb][0] * rs * gm.x / (1.f + __expf(-o0)), nS[vb][1] * rs * gm.y / (1.f + __expf(-o1)));
        r.y = pk2(nS[vb][2] * rs * gm.z / (1.f + __expf(-o2)), nS[vb][3] * rs * gm.w / (1.f + __expf(-o3)));
        *(v2u*)(F.MIX + row * DM + 512 + 128 * h + v0) = r;
    }
    __syncthreads();
}
__device__ __forceinline__ void merge_item(Frame& F, int mi) {
#pragma unroll
    for (int i = 0; i < 4; ++i) {
        const int idx = F.tid + 512 * i, ch = idx & 7, hd = (idx >> 3) & 7, tk = idx >> 6; const size_t tok = (size_t)32 * mi + tk;
        const float L0 = F.LSE[tok * 8 + hd], L1 = F.LSE[((size_t)TP + tok) * 8 + hd], L2 = F.LSE[((size_t)2 * TP + tok) * 8 + hd];
        const float mx = fmaxf(L0, fmaxf(L1, L2)); float w0 = ex2(L0 - mx), w1 = ex2(L1 - mx), w2 = ex2(L2 - mx); const float iW = 1.f / (w0 + w1 + w2); w0 *= iW; w1 *= iW; w2 *= iW;
        const size_t po = tok * 512 + hd * 64 + ch * 8;
        const v4u a = *(const v4u*)(F.PART + po), b = *(const v4u*)(F.PART + (size_t)TP * 512 + po), cc = *(const v4u*)(F.PART + (size_t)2 * TP * 512 + po);
        v4u o;
        o.x = pk2(w0 * bflo(a.x) + w1 * bflo(b.x) + w2 * bflo(cc.x), w0 * bfhi(a.x) + w1 * bfhi(b.x) + w2 * bfhi(cc.x));
        o.y = pk2(w0 * bflo(a.y) + w1 * bflo(b.y) + w2 * bflo(cc.y), w0 * bfhi(a.y) + w1 * bfhi(b.y) + w2 * bfhi(cc.y));
        o.z = pk2(w0 * bflo(a.z) + w1 * bflo(b.z) + w2 * bflo(cc.z), w0 * bfhi(a.z) + w1 * bfhi(b.z) + w2 * bfhi(cc.z));
        o.w = pk2(w0 * bflo(a.w) + w1 * bflo(b.w) + w2 * bflo(cc.w), w0 * bfhi(a.w) + w1 * bfhi(b.w) + w2 * bfhi(cc.w));
        *(v4u*)(F.MIX + tok * DM + hd * 64 + ch * 8) = o;
    }
}

__device__ __forceinline__ void p6_ln1(Frame& F) {
    const int gw = F.vcu * NWAVES + F.wave, NGW = F.G * NWAVES, lane = F.lane;
    f32x4 g1[4], g2[4];
#pragma unroll
    for (int j = 0; j < 4; ++j) { g1[j] = *(const f32x4*)(F.g_post + 256 * j + 4 * lane); g2[j] = *(const f32x4*)(F.g_ffn + 256 * j + 4 * lane); }
    for (int m = gw; m < MALL; m += NGW) {
        const float* xrow = m < TP ? F.xp + (size_t)m * DM : F.xs + (size_t)(m - TP) * DM;
        const float* mr = F.MIXED + (size_t)m * DM;
        f32x4 v[4], x[4]; float s = 0.f;
#pragma unroll
        for (int j = 0; j < 4; ++j) { v[j] = *(const f32x4*)(mr + 256 * j + 4 * lane); x[j] = *(const f32x4*)(xrow + 256 * j + 4 * lane); s += (v[j].x * v[j].x + v[j].y * v[j].y) + (v[j].z * v[j].z + v[j].w * v[j].w); }
        const float rs = rsqrtf(wave_sum(s) * (1.f / DM) + RMS_EPS); float s2 = 0.f;
#pragma unroll
        for (int j = 0; j < 4; ++j) { x[j] = x[j] + v[j] * rs * g1[j]; s2 += (x[j].x * x[j].x + x[j].y * x[j].y) + (x[j].z * x[j].z + x[j].w * x[j].w); }
        const float rs2 = rsqrtf(wave_sum(s2) * (1.f / DM) + RMS_EPS);
        float* orow = F.out + (size_t)m * DM; bf16* nrow = F.XN + (size_t)m * DM;
#pragma unroll
        for (int j = 0; j < 4; ++j) { *(f32x4*)(orow + 256 * j + 4 * lane) = x[j];
            v2u o; o.x = pk2(x[j].x * rs2 * g2[j].x, x[j].y * rs2 * g2[j].y); o.y = pk2(x[j].z * rs2 * g2[j].z, x[j].w * rs2 * g2[j].w); *(v2u*)(nrow + 256 * j + 4 * lane) = o; }
    }
}
__device__ __forceinline__ void p10_ln2(Frame& F) {
    const int gw = F.vcu * NWAVES + F.wave, NGW = F.G * NWAVES, lane = F.lane;
    f32x4 g1[4];
#pragma unroll
    for (int j = 0; j < 4; ++j) g1[j] = *(const f32x4*)(F.g_fpost + 256 * j + 4 * lane);
    for (int m = gw; m < MALL; m += NGW) {
        const float* yr = F.Y + (size_t)m * DM; float* orow = F.out + (size_t)m * DM;
        f32x4 v[4], x[4]; float s = 0.f;
#pragma unroll
        for (int j = 0; j < 4; ++j) { v[j] = *(const f32x4*)(yr + 256 * j + 4 * lane); x[j] = *(const f32x4*)(orow + 256 * j + 4 * lane); s += (v[j].x * v[j].x + v[j].y * v[j].y) + (v[j].z * v[j].z + v[j].w * v[j].w); }
        const float rs = rsqrtf(wave_sum(s) * (1.f / DM) + RMS_EPS);
#pragma unroll
        for (int j = 0; j < 4; ++j) *(f32x4*)(orow + 256 * j + 4 * lane) = x[j] + v[j] * rs * g1[j];
    }
}
__device__ __forceinline__ float gelu_tanh(float x) { const float t = 0.7978845608028654f * (x + 0.044715f * x * x * x); const float e = __expf(2.f * t); return 0.5f * x * (1.f + (1.f - 2.f / (e + 1.f))); }
__device__ __forceinline__ void ld8(const bf16* p, float (&o)[8]) { const v4u w = *(const v4u*)p; o[0] = bflo(w.x); o[1] = bfhi(w.x); o[2] = bflo(w.y); o[3] = bfhi(w.y); o[4] = bflo(w.z); o[5] = bfhi(w.z); o[6] = bflo(w.w); o[7] = bfhi(w.w); }
__device__ __forceinline__ void ld8f(const float* p, float (&o)[8]) { const f32x4 a = *(const f32x4*)p, b = *(const f32x4*)(p + 4); o[0] = a.x; o[1] = a.y; o[2] = a.z; o[3] = a.w; o[4] = b.x; o[5] = b.y; o[6] = b.z; o[7] = b.w; }
__device__ __forceinline__ void st8f(float* p, const float (&o)[8]) { *(f32x4*)p = (f32x4){o[0], o[1], o[2], o[3]}; *(f32x4*)(p + 4) = (f32x4){o[4], o[5], o[6], o[7]}; }
__device__ __forceinline__ void p8_conv(Frame& F) {
    const size_t gt = (size_t)F.vcu * (NWAVES * 64) + F.tid, NT = (size_t)F.G * (NWAVES * 64);
    constexpr int NCC = DFF / 8, NRB = MALL / 16;
    for (size_t wi = gt; wi < (size_t)NCC * NRB; wi += NT) {
        const int cc = (int)(wi % NCC), rb = (int)(wi / NCC), c0 = 8 * cc, jt = c0 >> 7, ii = c0 & 127, gcol = 256 * jt + ii, vcol = gcol + 128;
        float wg[3][8], wv[3][8], bg[8], bv[8];
#pragma unroll
        for (int k = 0; k < 3; ++k) { ld8f(F.conv_w + (size_t)k * NUP + c0, wg[k]); ld8f(F.conv_w + (size_t)k * NUP + DFF + c0, wv[k]); }
        ld8f(F.conv_b + c0, bg); ld8f(F.conv_b + DFF + c0, bv);
        const int row0 = 16 * rb; const bool samp = row0 >= TP;
        float g2[8], g1[8], v2[8], v1[8];
        if (!samp) {
            if (row0 == 0) {
#pragma unroll
                for (int e = 0; e < 8; ++e) { g2[e] = 0.f; g1[e] = 0.f; v2[e] = 0.f; v1[e] = 0.f; }
            } else { ld8(F.U + (size_t)(row0 - 2) * NUP + gcol, g2); ld8(F.U + (size_t)(row0 - 1) * NUP + gcol, g1); ld8(F.U + (size_t)(row0 - 2) * NUP + vcol, v2); ld8(F.U + (size_t)(row0 - 1) * NUP + vcol, v1); }
        }
        for (int rr = 0; rr < 16; ++rr) {
            const int row = row0 + rr;
            if (samp && (rr & 7) == 0) { const int b = (row - TP) >> 3; const float* cs = F.st_conv + (size_t)b * 2 * NUP;
                ld8f(cs + c0, g2); ld8f(cs + NUP + c0, g1); ld8f(cs + DFF + c0, v2); ld8f(cs + NUP + DFF + c0, v1); }
            float g0[8], v0[8]; ld8(F.U + (size_t)row * NUP + gcol, g0); ld8(F.U + (size_t)row * NUP + vcol, v0);
            float a[8];
#pragma unroll
            for (int e = 0; e < 8; ++e) { const float ug = bg[e] + wg[0][e] * g2[e] + wg[1][e] * g1[e] + wg[2][e] * g0[e]; const float uv = bv[e] + wv[0][e] * v2[e] + wv[1][e] * v1[e] + wv[2][e] * v0[e]; a[e] = gelu_tanh(ug) * uv; }
            v4u o; o.x = pk2(a[0], a[1]); o.y = pk2(a[2], a[3]); o.z = pk2(a[4], a[5]); o.w = pk2(a[6], a[7]);
            *(v4u*)(F.ACT + (size_t)row * DFF + c0) = o;
            if (!samp) { if (row >= TP - 2) { float* d = F.out + O_CONVP + (size_t)(row - (TP - 2)) * NUP; st8f(d + c0, g0); st8f(d + DFF + c0, v0); } }
            else if ((rr & 7) >= 6) { const int b = (row - TP) >> 3; float* d = F.out + O_CONVS + ((size_t)b * 2 + ((rr & 7) - 6)) * NUP; st8f(d + c0, g0); st8f(d + DFF + c0, v0); }
#pragma unroll
            for (int e = 0; e < 8; ++e) { g2[e] = g1[e]; g1[e] = g0[e]; v2[e] = v1[e]; v1[e] = v0[e]; }
        }
    }
}

struct Args { const float* in[22]; float* out; unsigned char* ws; int ph_lo, ph_hi; };
__global__ void __launch_bounds__(NWAVES * 64, 2) hymba_fwd(Args args) {
    extern __shared__ __attribute__((aligned(16))) unsigned char lds[];
    Frame F;
    F.lds = (LAS unsigned char*)lds;
    F.MISC = (volatile LAS unsigned*)(F.lds + MISC_OFF);
    F.tid = threadIdx.x; F.lane = F.tid & 63; F.wave = __builtin_amdgcn_readfirstlane(F.tid >> 6);
    F.G = gridDim.x; { const int bx = blockIdx.x; F.vcu = (F.G % 8 == 0) ? (bx % 8) * (F.G / 8) + bx / 8 : bx; }
    unsigned char* ws = args.ws;
    F.ctl = (gu32*)(ws + WS_CTL);
    F.xp = args.in[0]; F.xs = args.in[1]; F.cache_k = args.in[2]; F.cache_v = args.in[3]; F.st_C = args.in[4]; F.st_n = args.in[5]; F.st_m = args.in[6]; F.st_conv = args.in[7];
    F.rel_bias = args.in[8]; F.g_pre = args.in[9]; F.w_in = args.in[10]; F.b_i = args.in[11]; F.b_f = args.in[12]; F.g_ml = args.in[13]; F.w_out = args.in[14]; F.g_post = args.in[15];
    F.g_ffn = args.in[16]; F.w_up = args.in[17]; F.conv_w = args.in[18]; F.conv_b = args.in[19]; F.w_down = args.in[20]; F.g_fpost = args.in[21];
    F.out = args.out;
    F.Win_t = (bf16*)(ws + WS_WIN); F.Wout_t = (bf16*)(ws + WS_WOUT); F.Wup_t = (bf16*)(ws + WS_WUP); F.Wdn_t = (bf16*)(ws + WS_WDN);
    F.XN = (bf16*)(ws + WS_XN); F.Z = (bf16*)(ws + WS_Z); F.PART = (bf16*)(ws + WS_PART); F.CSNAP = (bf16*)(ws + WS_CSNAP); F.MIX = (bf16*)(ws + WS_MIX); F.U = (bf16*)(ws + WS_U); F.ACT = (bf16*)(ws + WS_ACT);
    F.Gt = (float*)(ws + WS_G); F.GB = (float*)(ws + WS_GB); F.CS = (float*)(ws + WS_CS); F.BT = (float*)(ws + WS_BT); F.LSE = (float*)(ws + WS_LSE); F.DN = (float*)(ws + WS_DN); F.NSNAP = (float*)(ws + WS_NSNAP);
    F.DC = (float*)(ws + WS_DC); F.MIXED = (float*)(ws + WS_MIXED); F.Y = (float*)(ws + WS_Y);
    for (int u = F.tid; u < (LDS_BYTES - LDSCTL_OFF) / 4; u += NWAVES * 64) ((LAS unsigned*)(F.lds + LDSCTL_OFF))[u] = 0u;
    __syncthreads();
    XcdBarrier bar = xcd_barrier_post((unsigned*)(F.ctl + CW_BAR), F.MISC + 8);
    const int lo = args.ph_lo, hi = args.ph_hi;
#ifdef ONLY
#define IN(k) ((k) == ONLY && lo <= (k) && (k) < hi)
#else
#define IN(k) (lo <= (k) && (k) < hi)
#endif
#define SEAM(k) do { if (IN(k) && IN((k) + 1)) xcd_barrier(bar); } while (0)
#ifndef DBL
#define DBL 0
#endif
#define REP(k) for (int rep_ = 0; rep_ < (((DBL >> (k)) & 1) ? 2 : 1); ++rep_)
    LAS float* ms = (LAS float*)(F.lds + MS_OFF);

#ifndef P0X
#define P0X 1
#endif
    if (IN(0)) { p0_prologue(F); if (P0X > 1) { __syncthreads(); p0_prologue(F); } } SEAM(0);
    if (IN(1)) {
        chunk_stats(F);
        pg8::Gemm g{F.XN, F.Win_t, MALL, NZ, DM}; pg8::StaticOrder S; S.init(MALL, NZ, F.G, (int)blockIdx.x);
        pg8::EpiZ E{F.Z, F.out};
        pg8::gemm_phase<pg8::EpiZ, pg8::StaticOrder, true, true>(F.lds + RING_OFF, g, S, E);
    } SEAM(1);
    if (IN(2)) {
        mscan_to_lds(F, ms);
        constexpr int NATT = 3072, NDC = 512, NSA = 256, NSM = 128;
        {
            AttnRegs R; int a = F.vcu;
            if (a < NATT) attn_load(F, a, R);
            for (; a < NATT; a += F.G) {
                bf16x8 qf0, qf1;
                attn_stage(F, a, R);
                attn_qload(F, a, qf0, qf1);
                __syncthreads();
                if (a + F.G < NATT) attn_load(F, a + F.G, R);
                attn_compute(F, a, qf0, qf1);
                __syncthreads();
            }
        }
        for (int it = NATT + F.vcu; it < NATT + NDC + NSA + NSM; it += F.G) {
            if (it < NATT + NDC) dc_unit(F, it - NATT, ms);
            else if (it < NATT + NDC + NSA) sattn_unit(F, it - NATT - NDC);
            else smlstm_unit(F, it - NATT - NDC - NSA);
        }
    } SEAM(2);
    if (IN(3)) { p3_scan(F); } SEAM(3);
    if (IN(4)) {
        mscan_to_lds(F, ms);
#ifndef P4X
#define P4X 1
#endif
        for (int it0 = F.vcu; it0 < P4X * 1024; it0 += F.G) { const int it = it0 & 1023; if (it < 512) mout_unit(F, it, ms); else merge_item(F, it - 512); }
    } SEAM(4);
    if (IN(5)) {
        pg8::Gemm g{F.MIX, F.Wout_t, MALL, DM, DM}; pg8::StaticOrder S; S.init(MALL, DM, F.G, (int)blockIdx.x);
        pg8::EpiF32 E{F.MIXED, DM};
        pg8::gemm_phase<pg8::EpiF32, pg8::StaticOrder, true, true>(F.lds + RING_OFF, g, S, E);
    } SEAM(5);
    if (IN(6)) { p6_ln1(F); } SEAM(6);
    if (IN(7)) {
        pg8::Gemm g{F.XN, F.Wup_t, MALL, NUP, DM}; pg8::StaticOrder S; S.init(MALL, NUP, F.G, (int)blockIdx.x);
        pg8::EpiBf16<0> E{F.U, NUP, nullptr, 0, 0, 1.f};
        pg8::gemm_phase<pg8::EpiBf16<0>, pg8::StaticOrder, true, true>(F.lds + RING_OFF, g, S, E);
    } SEAM(7);
    if (IN(8)) { p8_conv(F); } SEAM(8);
    if (IN(9)) {
        pg8::Gemm g{F.ACT, F.Wdn_t, MALL, DM, DFF}; pg8::StaticOrder S; S.init(MALL, DM, F.G, (int)blockIdx.x);
        pg8::EpiF32 E{F.Y, DM};
        pg8::gemm_phase<pg8::EpiF32, pg8::StaticOrder, true, true>(F.lds + RING_OFF, g, S, E);
    } SEAM(9);
    if (IN(10)) { p10_ln2(F); }
#undef IN
#undef SEAM
}

#ifndef N_LAUNCHES
#define N_LAUNCHES 1
#endif
extern "C" void kernel_launch(void* const* d_in, const int* in_sizes, int n_in, void* d_out, int out_size, void* d_ws, size_t ws_size, hipStream_t stream) {
    static int grid = 0;
    if (grid == 0) {
        if (n_in != 22 || in_sizes[0] != TP * DM || (size_t)out_size != O_END || ws_size < WS_END) {
            fprintf(stderr, "kernel_launch: unexpected shapes: n_in %d in0 %d out %d ws %zu (need %zu)\n", n_in, n_in > 0 ? in_sizes[0] : -1, out_size, ws_size, (size_t)WS_END); grid = -1; return; }
        int dev = 0, cus = 0, per_cu = 0;
        if (hipGetDevice(&dev) != hipSuccess || hipDeviceGetAttribute(&cus, hipDeviceAttributeMultiprocessorCount, dev) != hipSuccess) { grid = -1; return; }
        if (hipFuncSetAttribute((const void*)hymba_fwd, hipFuncAttributeMaxDynamicSharedMemorySize, LDS_BYTES) != hipSuccess) { fprintf(stderr, "kernel_launch: hipFuncSetAttribute failed\n"); grid = -1; return; }
        if (hipOccupancyMaxActiveBlocksPerMultiprocessor(&per_cu, (const void*)hymba_fwd, NWAVES * 64, LDS_BYTES) != hipSuccess || per_cu < 1) {
            fprintf(stderr, "kernel_launch: occupancy query reports %d workgroups per CU; nothing launched\n", per_cu); (void)hipGetLastError(); grid = -1; return; }
        grid = cus;
    }
    if (grid < 0) return;
    if (hipMemsetAsync((char*)d_ws + WS_CTL, 0, CTL_ZERO_BYTES, stream) != hipSuccess) { fprintf(stderr, "kernel_launch: memset failed\n"); return; }
    Args a{};
    for (int i = 0; i < 22; ++i) a.in[i] = (const float*)d_in[i];
    a.out = (float*)d_out; a.ws = (unsigned char*)d_ws;
#if N_LAUNCHES == 1
    a.ph_lo = 0; a.ph_hi = 11;
    hipLaunchKernelGGL(hymba_fwd, dim3(grid), dim3(NWAVES * 64), LDS_BYTES, stream, a);
#else
    for (int p = 0; p < 11; ++p) { a.ph_lo = p; a.ph_hi = p + 1; hipLaunchKernelGGL(hymba_fwd, dim3(grid), dim3(NWAVES * 64), LDS_BYTES, stream, a); }
#endif
    const hipError_t le = hipPeekAtLastError();
    if (le != hipSuccess) fprintf(stderr, "kernel_launch: launch failed: %s (grid %d)\n", hipGetErrorName(le), grid);
}
```
